# Optimizing an MI355X kernel written in HIP

```python
import math
import jax, jax.numpy as jnp
from jax import lax
import numpy as np

D_MODEL = 1024
BATCH = 16
SEQ = 2048
DEPTH = 2

N_MIXERS = 2
N_HEADS = 16
N_KV_HEADS = 4
HEAD_DIM = 64
GROUP = N_HEADS // N_KV_HEADS
Q_DIM = N_HEADS * HEAD_DIM
KV_DIM = N_KV_HEADS * HEAD_DIM
QKV_DIM = Q_DIM + 2 * KV_DIM
WINDOW = 128
BLOCK = 128
ROPE_THETA = 10000.0
CONV_WIDTH = 3
CONV_DIM = D_MODEL
D_FF = 2816
RMS_EPS = 1e-6
NEG_INF = -1e30
N_ATTN_LAYERS = (DEPTH + 1) // 2
N_CONV_LAYERS = DEPTH // 2

kernel_name = "hybrid_swa_shortconv_encoder"


def _rmsnorm(x, g):
    xf = x.astype(jnp.float32)
    y = xf * lax.rsqrt(jnp.mean(xf * xf, axis=-1, keepdims=True) + RMS_EPS)
    return (y * g.astype(jnp.float32)).astype(x.dtype)


def _dwconv3(x, w):
    xp = jnp.pad(x, ((0, 0), (1, 1), (0, 0)))
    return xp[:, :-2] * w[0] + xp[:, 1:-1] * w[1] + xp[:, 2:] * w[2]


def _rope_tables(positions, dtype):
    inv_freq = ROPE_THETA ** (-jnp.arange(0, HEAD_DIM, 2, dtype=jnp.float32) / HEAD_DIM)
    ang = positions.astype(jnp.float32)[:, None] * inv_freq[None, :]
    ang = jnp.concatenate([ang, ang], axis=-1)
    return jnp.cos(ang).astype(dtype), jnp.sin(ang).astype(dtype)


def _rotate_half(x):
    x1, x2 = jnp.split(x, 2, axis=-1)
    return jnp.concatenate([-x2, x1], axis=-1)


def _windowed_gqa(h, w_qkv, sink, w_o, cos, sin):
    B, S, _ = h.shape
    nb = S // BLOCK
    qkv = h @ w_qkv
    q = qkv[..., :Q_DIM].reshape(B, S, N_KV_HEADS, GROUP, HEAD_DIM)
    k = qkv[..., Q_DIM:Q_DIM + KV_DIM].reshape(B, S, N_KV_HEADS, HEAD_DIM)
    v = qkv[..., Q_DIM + KV_DIM:].reshape(B, S, N_KV_HEADS, HEAD_DIM)
    cq, sq = cos[None, :, None, None, :], sin[None, :, None, None, :]
    ck, sk = cos[None, :, None, :], sin[None, :, None, :]
    q = q * cq + _rotate_half(q) * sq
    k = k * ck + _rotate_half(k) * sk

    q_blk = q.reshape(B, nb, BLOCK, N_KV_HEADS, GROUP, HEAD_DIM).transpose(1, 0, 2, 3, 4, 5)

    def band(t):
        tp = jnp.pad(t, ((0, 0), (BLOCK, BLOCK), (0, 0), (0, 0)))
        tp = tp.reshape(B, nb + 2, BLOCK, N_KV_HEADS, HEAD_DIM)
        win = jnp.concatenate([tp[:, 0:nb], tp[:, 1:nb + 1], tp[:, 2:nb + 2]], axis=2)
        return win.transpose(1, 0, 2, 3, 4)

    k_win, v_win = band(k), band(v)
    r = jnp.arange(BLOCK)[:, None]
    t = jnp.arange(3 * BLOCK)[None, :]
    in_band = jnp.abs(t - BLOCK - r) <= WINDOW
    sink_f = sink.astype(jnp.float32).reshape(N_KV_HEADS, GROUP)[None, :, :, None, None]
    scale = 1.0 / math.sqrt(HEAD_DIM)

    def one_block(args):
        blk, qb, kb, vb = args
        k_pos = blk * BLOCK - BLOCK + t
        valid = in_band & (k_pos >= 0) & (k_pos < S)
        s = jnp.einsum('bqngd,bknd->bngqk', qb, kb).astype(jnp.float32) * scale
        s = jnp.where(valid[None, None, None], s, NEG_INF)
        m = jnp.maximum(jnp.max(s, axis=-1, keepdims=True), sink_f)
        p = jnp.exp(s - m)
        denom = jnp.sum(p, axis=-1, keepdims=True) + jnp.exp(sink_f - m)
        p = (p / denom).astype(vb.dtype)
        return jnp.einsum('bngqk,bknd->bqngd', p, vb)

    o = lax.map(one_block, (jnp.arange(nb), q_blk, k_win, v_win))
    o = o.transpose(1, 0, 2, 3, 4, 5).reshape(B, S, Q_DIM)
    return o @ w_o


def _short_conv_mixer(h, w_in, conv_w, w_out):
    bcx = h @ w_in
    b_gate, c_gate, xv = jnp.split(bcx, 3, axis=-1)
    y = b_gate * _dwconv3(c_gate * xv, conv_w)
    return y @ w_out


def _conv_glu_ffn(h, w_gate_up, conv_w, w_down):
    gu = h @ w_gate_up
    g, u = jnp.split(gu, 2, axis=-1)
    return (jax.nn.silu(_dwconv3(g, conv_w)) * u) @ w_down


def setup_inputs(seed: int = 0) -> dict:
    key = jax.random.key(seed)
    ks = jax.random.split(key, 12)
    f32 = jnp.float32

    def dense(k, shape, fan_in):
        return jax.random.normal(k, shape, f32) * fan_in ** -0.5

    return {
        "x": jax.random.normal(ks[0], (BATCH, SEQ, D_MODEL), f32),
        "positions": jnp.arange(SEQ, dtype=jnp.int32),
        "attn_w_qkv": dense(ks[1], (N_ATTN_LAYERS, D_MODEL, QKV_DIM), D_MODEL),
        "attn_sink": 0.5 * jax.random.normal(ks[2], (N_ATTN_LAYERS, N_HEADS), f32),
        "attn_w_o": dense(ks[3], (N_ATTN_LAYERS, Q_DIM, D_MODEL), Q_DIM),
        "conv_w_in": dense(ks[4], (N_CONV_LAYERS, D_MODEL, 3 * CONV_DIM), D_MODEL),
        "conv_w": dense(ks[5], (N_CONV_LAYERS, CONV_WIDTH, CONV_DIM), CONV_WIDTH),
        "conv_w_out": dense(ks[6], (N_CONV_LAYERS, CONV_DIM, D_MODEL), CONV_DIM),
        "norm_gains": 1.0 + 0.05 * jax.random.normal(ks[7], (DEPTH, 4, D_MODEL), f32),
        "ffn_w_gate_up": dense(ks[8], (DEPTH, D_MODEL, 2 * D_FF), D_MODEL),
        "ffn_conv_w": dense(ks[9], (DEPTH, CONV_WIDTH, D_FF), CONV_WIDTH),
        "ffn_w_down": dense(ks[10], (DEPTH, D_FF, D_MODEL), D_FF),
    }


def reference(x, positions, attn_w_qkv, attn_sink, attn_w_o, conv_w_in, conv_w, conv_w_out,
              norm_gains, ffn_w_gate_up, ffn_conv_w, ffn_w_down):
    cos, sin = _rope_tables(positions, x.dtype)
    h = x
    for i in range(DEPTH):
        g_pre_mix, g_post_mix, g_pre_ffn, g_post_ffn = (norm_gains[i, j] for j in range(4))
        hn = _rmsnorm(h, g_pre_mix)
        if i % N_MIXERS == 0:
            a = i // N_MIXERS
            mix = _windowed_gqa(hn, attn_w_qkv[a], attn_sink[a], attn_w_o[a], cos, sin)
        else:
            c = i // N_MIXERS
            mix = _short_conv_mixer(hn, conv_w_in[c], conv_w[c], conv_w_out[c])
        h = h + _rmsnorm(mix, g_post_mix)
        f = _conv_glu_ffn(_rmsnorm(h, g_pre_ffn), ffn_w_gate_up[i], ffn_conv_w[i], ffn_w_down[i])
        h = h + _rmsnorm(f, g_post_ffn)
    return h
```

```cpp
#include <hip/hip_runtime.h>
#include <hip/hip_cooperative_groups.h>
#include <cstdio>
#include <cstdint>
namespace cg = cooperative_groups;
namespace pg8 {
#define PG8_LAS __attribute__((address_space(3)))
typedef unsigned short bf16_t;
typedef short bf16x8 __attribute__((ext_vector_type(8)));
typedef float f32x4 __attribute__((ext_vector_type(4)));
typedef unsigned u32x4 __attribute__((ext_vector_type(4)));
constexpr int BM = 256, BK = 64, HALF = 128, HTB = HALF * BK * 2  , STAGE_BYTES = 8 * HTB, NXCD = 8, WGM = 8;

__host__ __device__ __forceinline__ int lds_byte(int r, int c) { const int st = (r >> 4) * 2 + (c >> 5), rr = r & 15, cc = c & 31, ob = rr * 64 + cc * 2; return st * 1024 + (ob ^ (((ob >> 9) & 1) << 5)); }
__host__ __device__ __forceinline__ void stage_rc(int b, int& R, int& C) { const int st = b / 1024, sb = b % 1024, swz = sb ^ (((sb >> 9) & 1) << 5); R = (st >> 1) * 16 + swz / 64; C = (st & 1) * 32 + (swz % 64) / 2; }
__host__ __device__ __forceinline__ int perm32(int rho) { const int n = rho >> 4, i = rho & 15; return 8 * (i >> 2) + 4 * n + (i & 3); }

typedef unsigned u32x2 __attribute__((ext_vector_type(2)));
struct Unit { int pm, pn, w; };
struct Gemm { const bf16_t* A; const bf16_t* Bt; int M, N, K; const bf16_t* A2; const bf16_t* Bt2; };

struct StaticOrder {
    int nM, nN, nwg, G, c, n2;
    __host__ __device__ void init(int M, int N, int G_, int c_, int n2_ = 0) { nM = M / BM; nN = N / BM; nwg = nM * nN; G = G_; c = c_; n2 = n2_; }
    __host__ __device__ bool next(int i, Unit& u) const {
        const long L = (long)i * G + c; if (L >= nwg + n2) return false;
        if (L >= nwg) { u.w = 1; u.pm = 0; u.pn = (int)(L - nwg); return true; }
        u.w = 0;
        int wgid = (int)L; { const int q = nwg / NXCD, r = nwg % NXCD, xcd = wgid % NXCD, off = wgid / NXCD; wgid = (xcd < r ? xcd * (q + 1) : r * (q + 1) + (xcd - r) * q) + off; }
        const int nig = WGM * nN, gid = wgid / nig, fm = gid * WGM, gsz = (nM - fm) < WGM ? (nM - fm) : WGM;
        u.pm = fm + ((wgid % nig) % gsz); u.pn = (wgid % nig) / gsz; return true;
    }
    __device__ __forceinline__ void a_ready(const Unit&) const {}
    __device__ __forceinline__ void done(const Unit&) const {}
};

__device__ __forceinline__ unsigned cvt_pk_bf16(float lo, float hi) { unsigned r; asm volatile("v_cvt_pk_bf16_f32 %0, %1, %2" : "=v"(r) : "v"(lo), "v"(hi)); return r; }
__device__ __forceinline__ u32x4 pack8(const f32x4 a, const f32x4 b) { u32x4 w; w.x = cvt_pk_bf16(a[0], a[1]); w.y = cvt_pk_bf16(a[2], a[3]); w.z = cvt_pk_bf16(b[0], b[1]); w.w = cvt_pk_bf16(b[2], b[3]); return w; }
__device__ __forceinline__ f32x4 bf_lo4(const u32x4 w) { return (f32x4){__uint_as_float(w.x << 16), __uint_as_float(w.x & 0xffff0000u), __uint_as_float(w.y << 16), __uint_as_float(w.y & 0xffff0000u)}; }
__device__ __forceinline__ f32x4 bf_hi4(const u32x4 w) { return (f32x4){__uint_as_float(w.z << 16), __uint_as_float(w.z & 0xffff0000u), __uint_as_float(w.w << 16), __uint_as_float(w.w & 0xffff0000u)}; }

struct EpiStore {
    static constexpr bool PERM = true, AFTER_DRAIN = false;
    bf16_t* O; int ldc;
    __device__ __forceinline__ void operator()(const f32x4 (&acc)[2][2][4][2], const Unit& u, int wr, int wc, int fr, int fq) const {
        const int row0 = u.pm * BM + wr * 64 + fr, col0 = u.pn * BM + wc * 32 + 8 * fq;
#pragma unroll
        for (int ai = 0; ai < 2; ++ai)
#pragma unroll
            for (int m = 0; m < 4; ++m) { bf16_t* rowp = O + (size_t)(row0 + ai * HALF + m * 16) * ldc + col0;
#pragma unroll
                for (int bj = 0; bj < 2; ++bj) *(u32x4*)(rowp + bj * HALF) = pack8(acc[ai][bj][m][0], acc[ai][bj][m][1]); }
    }
};

struct EpiQKV {
    static constexpr bool PERM = true, AFTER_DRAIN = false;
    bf16_t* Q; long offK, offV; const float* rcos; const float* rsin; float qscale; int mtok;
    __device__ __forceinline__ void operator()(const f32x4 (&acc)[2][2][4][2], const Unit& u, int wr, int wc, int fr, int fq) const {
        const bool isv = u.w != 0, isq = u.pn < 4;
        bf16_t* base = Q + (isv ? offV : (isq ? 0L : offK)); const int ldc = isv ? mtok : (isq ? 1024 : 256), colt = (isv || isq) ? u.pn * BM : 0; const float sc = (!isv && isq) ? qscale : 1.0f;
        const int i0 = 4 * ((wc & 1) * 4 + fq);
#pragma unroll
        for (int ai = 0; ai < 2; ++ai)
#pragma unroll
            for (int m = 0; m < 4; ++m) {
                const int row = u.pm * BM + ai * HALF + wr * 64 + m * 16 + fr, s = row & 2047;
                f32x4 c = (f32x4){1.f, 1.f, 1.f, 1.f}, sn = (f32x4){0.f, 0.f, 0.f, 0.f};
                if (!isv) { c = *(const f32x4*)(rcos + s * 32 + i0) * sc; sn = *(const f32x4*)(rsin + s * 32 + i0) * sc; }
                bf16_t* rowp = base + (size_t)row * ldc + colt + wc * 32 + 8 * fq;
#pragma unroll
                for (int bj = 0; bj < 2; ++bj) { const f32x4 x1 = acc[ai][bj][m][0], x2 = acc[ai][bj][m][1];
                    *(u32x4*)(rowp + bj * HALF) = pack8(x1 * c - x2 * sn, x2 * c + x1 * sn); }
                if (m & 1) asm volatile("" ::: "memory");
            }
    }
};

struct EpiCX {
    static constexpr bool PERM = true, AFTER_DRAIN = false;
    bf16_t* P;
    __device__ __forceinline__ void operator()(const f32x4 (&acc)[2][2][4][2], const Unit& u, int wr, int wc, int fr, int fq) const {
        const int row0 = u.pm * BM + wr * 64 + fr, col0 = u.pn * HALF + wc * 32 + 8 * fq;
#pragma unroll
        for (int ai = 0; ai < 2; ++ai)
#pragma unroll
            for (int m = 0; m < 4; ++m)
                *(u32x4*)(P + (size_t)(row0 + ai * HALF + m * 16) * 1024 + col0) = pack8(acc[ai][0][m][0] * acc[ai][1][m][0], acc[ai][0][m][1] * acc[ai][1][m][1]);
    }
};

template <int MODE> struct EpiConv {
    static constexpr bool PERM = true, AFTER_DRAIN = false;
    const bf16_t* G; const float* cw; bf16_t* O; int ldc;
    __device__ __forceinline__ void operator()(const f32x4 (&acc)[2][2][4][2], const Unit& u, int wr, int wc, int fr, int fq) const {
        const int row0 = u.pm * BM + wr * 64 + fr;
#pragma unroll
        for (int bj = 0; bj < 2; ++bj) {
            const int col = u.pn * BM + bj * HALF + wc * 32 + 8 * fq;
            const f32x4 w0a = *(const f32x4*)(cw + col), w0b = *(const f32x4*)(cw + col + 4);
            const f32x4 w1a = *(const f32x4*)(cw + ldc + col), w1b = *(const f32x4*)(cw + ldc + col + 4);
            const f32x4 w2a = *(const f32x4*)(cw + 2 * ldc + col), w2b = *(const f32x4*)(cw + 2 * ldc + col + 4);
#pragma unroll
            for (int ai = 0; ai < 2; ++ai)
#pragma unroll
                for (int m = 0; m < 4; ++m) {
                    const int row = row0 + ai * HALF + m * 16, s = row & 2047;
                    const bf16_t* gp = G + (size_t)row * ldc + col;
                    const u32x4 zc = *(const u32x4*)gp;
                    u32x4 zp = (u32x4){0u, 0u, 0u, 0u}, zn = (u32x4){0u, 0u, 0u, 0u};
                    if (s > 0) zp = *(const u32x4*)(gp - ldc);
                    if (s < 2047) zn = *(const u32x4*)(gp + ldc);
                    f32x4 za = w0a * bf_lo4(zp) + w1a * bf_lo4(zc) + w2a * bf_lo4(zn);
                    f32x4 zb = w0b * bf_hi4(zp) + w1b * bf_hi4(zc) + w2b * bf_hi4(zn);
                    f32x4 oa, ob;
                    if (MODE == 0) { oa = acc[ai][bj][m][0] * za; ob = acc[ai][bj][m][1] * zb; }
                    else {
#pragma unroll
                        for (int e = 0; e < 4; ++e) {
                            oa[e] = za[e] * __builtin_amdgcn_rcpf(1.0f + __builtin_amdgcn_exp2f(za[e] * -1.4426950408889634f)) * acc[ai][bj][m][0][e];
                            ob[e] = zb[e] * __builtin_amdgcn_rcpf(1.0f + __builtin_amdgcn_exp2f(zb[e] * -1.4426950408889634f)) * acc[ai][bj][m][1][e]; }
                    }
                    *(u32x4*)(O + (size_t)row * ldc + col) = pack8(oa, ob);
                    if (m & 1) asm volatile("" ::: "memory");
                }
        }
    }
};

template <class Epi, class Sched, bool ALIGN_EPI = false, bool SP2 = false>
__device__ __forceinline__ void gemm_phase(PG8_LAS unsigned char* lds, const Gemm g, const Sched& S, const Epi& E) {
    int tid_ = threadIdx.x; asm volatile("" : "+v"(tid_));
    const int tid = tid_, wid = __builtin_amdgcn_readfirstlane(tid >> 6), lane = tid & 63, wr = wid >> 2, wc = wid & 3, fr = lane & 15, fq = lane >> 4;
    const int K = g.K, nt = K / BK;
    unsigned voffA[2], voffB[2];
#pragma unroll
    for (int i = 0; i < 2; ++i) { int R, C; stage_rc(tid * 16 + i * 8192, R, C); const int Rb = Epi::PERM ? ((R & ~31) + perm32(R & 31)) : R;
        voffA[i] = (unsigned)(R * K + C) * 2u; voffB[i] = (unsigned)(Rb * K + C) * 2u; }
    const size_t kstep = (size_t)(BK * 2);
    const size_t hstep = (size_t)HALF * K * 2;
    const size_t tstep = 2 * hstep;
    const unsigned ldsw = (unsigned)wid * 1024u;
    const int aoff = lds_byte(wr * 64 + fr, fq * 8), boff = lds_byte(wc * 32 + fr, fq * 8);
#define PG8_SA(b, h) (((b) * 2 + (h)) * HTB)
#define PG8_SB(b, h) ((4 + (b) * 2 + (h)) * HTB)
#define PG8_STAGE(bufoff, gbase, voff) do { _Pragma("unroll") for (int _i = 0; _i < 2; ++_i) \
        __builtin_amdgcn_global_load_lds((const unsigned*)((const char*)(gbase) + (voff)[_i]), (PG8_LAS unsigned*)(lds + (bufoff) + ldsw + _i * 8192), 16, 0, 0); } while (0)
#define PG8_LDA(dst, b, h) do { _Pragma("unroll") for (int m = 0; m < 4; ++m) _Pragma("unroll") for (int k = 0; k < 2; ++k) dst[m][k] = *(const PG8_LAS bf16x8*)(lds + PG8_SA(b, h) + aoff + m * 2048 + k * 1024); } while (0)
#define PG8_LDB(dst, b, h) do { _Pragma("unroll") for (int n = 0; n < 2; ++n) _Pragma("unroll") for (int k = 0; k < 2; ++k) dst[n][k] = *(const PG8_LAS bf16x8*)(lds + PG8_SB(b, h) + boff + n * 2048 + k * 1024); } while (0)
#define PG8_MMA(ai, bj, At, Bt) do { __builtin_amdgcn_s_setprio(1); _Pragma("unroll") for (int m = 0; m < 4; ++m) _Pragma("unroll") for (int n = 0; n < 2; ++n) _Pragma("unroll") for (int k = 0; k < 2; ++k) \
        acc[ai][bj][m][n] = __builtin_amdgcn_mfma_f32_16x16x32_bf16(Bt[n][k], At[m][k], acc[ai][bj][m][n], 0, 0, 0); __builtin_amdgcn_s_setprio(0); } while (0)
#define PG8_WAIT_V(n) asm volatile("s_waitcnt vmcnt(" #n ")" ::: "memory")
#define PG8_WAIT_L(n) asm volatile("s_waitcnt lgkmcnt(" #n ")" ::: "memory")
#define PG8_BAR __builtin_amdgcn_s_barrier()
#define PG8_SCHED __builtin_amdgcn_sched_barrier(0)
    Unit cur, nxt; int ui = 0;
    if (!S.next(0, cur)) return;
    f32x4 acc[2][2][4][2];
#pragma unroll
    for (int a = 0; a < 2; ++a)
#pragma unroll
        for (int b = 0; b < 2; ++b)
#pragma unroll
            for (int m = 0; m < 4; ++m)
#pragma unroll
                for (int n = 0; n < 2; ++n) acc[a][b][m][n] = (f32x4){0.f, 0.f, 0.f, 0.f};
    bf16x8 At[4][2], B0[2][2], B1[2][2];
    const char* cA = (const char*)(cur.w ? g.A2 : g.A) + (size_t)cur.pm * tstep; const char* cB = (const char*)(cur.w ? g.Bt2 : g.Bt) + (size_t)cur.pn * tstep;
    S.a_ready(cur);
    if constexpr (SP2) {
        PG8_STAGE(PG8_SB(0, 0), cB, voffB); PG8_STAGE(PG8_SB(0, 1), cB + hstep, voffB); PG8_STAGE(PG8_SA(0, 0), cA, voffA); PG8_STAGE(PG8_SA(0, 1), cA + hstep, voffA);
        if (wr == 1) PG8_BAR;
        PG8_WAIT_V(2); PG8_BAR;
        PG8_STAGE(PG8_SB(1, 0), cB + kstep, voffB); PG8_STAGE(PG8_SA(1, 0), cA + kstep, voffA); PG8_STAGE(PG8_SB(1, 1), cB + hstep + kstep, voffB);
        PG8_WAIT_V(6); PG8_BAR;
    } else {
        PG8_STAGE(PG8_SB(0, 0), cB, voffB); PG8_STAGE(PG8_SA(0, 0), cA, voffA); PG8_STAGE(PG8_SB(0, 1), cB + hstep, voffB); PG8_STAGE(PG8_SA(0, 1), cA + hstep, voffA);
        if (wr == 1) PG8_BAR;
        PG8_WAIT_V(4); PG8_BAR;
        PG8_STAGE(PG8_SB(1, 0), cB + kstep, voffB); PG8_STAGE(PG8_SA(1, 0), cA + kstep, voffA); PG8_STAGE(PG8_SB(1, 1), cB + hstep + kstep, voffB);
        PG8_WAIT_V(6); PG8_BAR;
    }
    for (;;) {
        const bool has_next = S.next(ui + 1, nxt);
        const char* nA = has_next ? (const char*)(nxt.w ? g.A2 : g.A) + (size_t)nxt.pm * tstep : cA; const char* nB = has_next ? (const char*)(nxt.w ? g.Bt2 : g.Bt) + (size_t)nxt.pn * tstep : cB;
        for (int t = 0; t < nt; t += 2) {
            const bool last = (t == nt - 2);
            const char* a1 = cA + (size_t)(t + 1) * kstep;
            const char* a2 = last ? nA : cA + (size_t)(t + 2) * kstep; const char* b2 = last ? nB : cB + (size_t)(t + 2) * kstep;
            const char* a3 = a2 + kstep; const char* b3 = b2 + kstep;
            if (last && has_next) S.a_ready(nxt);
            if constexpr (SP2) {
            PG8_LDB(B0, 0, 0); PG8_LDB(B1, 0, 1); PG8_SCHED; PG8_LDA(At, 0, 0); PG8_STAGE(PG8_SA(1, 1), a1 + hstep, voffA);
            PG8_WAIT_V(8); PG8_WAIT_L(0); PG8_BAR; PG8_MMA(0, 0, At, B0); PG8_MMA(0, 1, At, B1); PG8_BAR; PG8_SCHED;
            PG8_LDA(At, 0, 1); PG8_STAGE(PG8_SB(0, 0), b2, voffB); PG8_STAGE(PG8_SB(0, 1), b2 + hstep, voffB); PG8_STAGE(PG8_SA(0, 0), a2, voffA);
            PG8_WAIT_V(8); PG8_WAIT_L(0); PG8_BAR; PG8_MMA(1, 0, At, B0); PG8_MMA(1, 1, At, B1); PG8_BAR; PG8_SCHED;
            PG8_LDB(B0, 1, 0); PG8_LDB(B1, 1, 1); PG8_SCHED; PG8_LDA(At, 1, 0); PG8_STAGE(PG8_SA(0, 1), a2 + hstep, voffA);
            PG8_WAIT_V(8); PG8_WAIT_L(0); PG8_BAR; PG8_MMA(0, 0, At, B0); PG8_MMA(0, 1, At, B1); PG8_BAR; PG8_SCHED;
            PG8_LDA(At, 1, 1); PG8_STAGE(PG8_SB(1, 0), b3, voffB); PG8_STAGE(PG8_SB(1, 1), b3 + hstep, voffB); PG8_STAGE(PG8_SA(1, 0), a3, voffA);
            PG8_WAIT_V(8); PG8_WAIT_L(0); PG8_BAR; PG8_MMA(1, 0, At, B0); PG8_MMA(1, 1, At, B1); PG8_BAR; PG8_SCHED;
            } else {
            PG8_LDB(B0, 0, 0); PG8_SCHED; PG8_LDA(At, 0, 0); PG8_STAGE(PG8_SA(1, 1), a1 + hstep, voffA);
            PG8_WAIT_L(8); PG8_BAR; PG8_WAIT_L(0); PG8_MMA(0, 0, At, B0); PG8_BAR; PG8_SCHED;
            PG8_LDB(B1, 0, 1); PG8_STAGE(PG8_SB(0, 0), b2, voffB);
            PG8_BAR; PG8_WAIT_L(0); PG8_MMA(0, 1, At, B1); PG8_BAR;
            PG8_LDA(At, 0, 1); PG8_STAGE(PG8_SA(0, 0), a2, voffA);
            PG8_BAR; PG8_WAIT_L(0); PG8_MMA(1, 0, At, B0); PG8_BAR; PG8_SCHED;
            PG8_STAGE(PG8_SB(0, 1), b2 + hstep, voffB);
            PG8_WAIT_V(6); PG8_BAR; PG8_MMA(1, 1, At, B1); PG8_BAR;
            PG8_LDB(B0, 1, 0); PG8_SCHED; PG8_LDA(At, 1, 0); PG8_STAGE(PG8_SA(0, 1), a2 + hstep, voffA);
            PG8_WAIT_L(8); PG8_BAR; PG8_WAIT_L(0); PG8_MMA(0, 0, At, B0); PG8_BAR; PG8_SCHED;
            PG8_LDB(B1, 1, 1); PG8_STAGE(PG8_SB(1, 0), b3, voffB);
            PG8_BAR; PG8_WAIT_L(0); PG8_MMA(0, 1, At, B1); PG8_BAR;
            PG8_LDA(At, 1, 1); PG8_STAGE(PG8_SA(1, 0), a3, voffA);
            PG8_BAR; PG8_WAIT_L(0); PG8_MMA(1, 0, At, B0); PG8_BAR; PG8_SCHED;
            PG8_STAGE(PG8_SB(1, 1), b3 + hstep, voffB);
            PG8_WAIT_V(6); PG8_BAR; PG8_MMA(1, 1, At, B1); PG8_BAR;
            }
        }
        if constexpr (ALIGN_EPI) { if (wr == 0) PG8_BAR; }
        if constexpr (!Epi::AFTER_DRAIN) { E(acc, cur, wr, wc, fr, fq); S.done(cur); }
        if (!has_next) break;
#pragma unroll
        for (int a = 0; a < 2; ++a)
#pragma unroll
            for (int b = 0; b < 2; ++b)
#pragma unroll
                for (int m = 0; m < 4; ++m)
#pragma unroll
                    for (int n = 0; n < 2; ++n) acc[a][b][m][n] = (f32x4){0.f, 0.f, 0.f, 0.f};
        cur = nxt; cA = nA; cB = nB; ++ui;
        if constexpr (ALIGN_EPI) { if (wr == 1) PG8_BAR; }
    }
    PG8_WAIT_V(0);
    if constexpr (!ALIGN_EPI) { if (wr == 0) PG8_BAR; }
    PG8_BAR;
    if constexpr (Epi::AFTER_DRAIN) { E.fused(acc, cur, wr, wc, fr, fq, lds, wid, lane); S.done(cur); }
#undef PG8_SA
#undef PG8_SB
#undef PG8_STAGE
#undef PG8_LDA
#undef PG8_LDB
#undef PG8_MMA
#undef PG8_WAIT_V
#undef PG8_WAIT_L
#undef PG8_BAR
#undef PG8_SCHED
}
}

constexpr int BATCH = 16, SEQ = 2048, DM = 1024, MTOK = BATCH * SEQ, NQKV = 1536, FF = 2816, NH = 16, NKV = 4, HD = 64;
constexpr float RMS_EPS = 1e-6f, LOG2E = 1.4426950408889634f;
constexpr int NWAVES = 8;
#define LAS __attribute__((address_space(3)))
typedef unsigned short bf16;
typedef float f32x4 __attribute__((ext_vector_type(4)));
typedef float f32x16 __attribute__((ext_vector_type(16)));
typedef unsigned u32x4 __attribute__((ext_vector_type(4)));
typedef unsigned u32x2 __attribute__((ext_vector_type(2)));
typedef short bf16x8 __attribute__((ext_vector_type(8)));

constexpr size_t MiB = 1u << 20;
constexpr size_t WS_WQKV = 0, WS_WO = 3 * MiB, WS_WIN = 5 * MiB, WS_WOUT = 11 * MiB, WS_WGU = 13 * MiB  , WS_WD = 35 * MiB  ;
constexpr size_t WS_ROPE = 46 * MiB;
constexpr size_t WS_XN = 48 * MiB;
constexpr size_t WS_Y = 112 * MiB;
constexpr size_t WS_G = 112 * MiB;
constexpr size_t WS_ACT = 288 * MiB;
constexpr size_t WS_Q = 288 * MiB, WS_K = 352 * MiB, WS_VT = 368 * MiB;
constexpr size_t WS_P = 288 * MiB, WS_Y2 = 352 * MiB;
constexpr size_t WS_END = 464 * MiB;

constexpr int LDS_BYTES = 147456;

__device__ __forceinline__ unsigned f2bf(float f) { unsigned u = __builtin_bit_cast(unsigned, f); return (u + 0x7fffu + ((u >> 16) & 1u)) >> 16; }
__device__ __forceinline__ unsigned pk2(float lo, float hi) { return f2bf(lo) | (f2bf(hi) << 16); }
__device__ __forceinline__ float wave_sum(float v) {
#pragma unroll
    for (int o = 1; o < 64; o <<= 1) v += __shfl_xor(v, o);
    return v;
}

namespace att {
constexpr int KSTR = 144, VSTR = 776, LDS_K = 0, LDS_V = 384 * KSTR;
__device__ __forceinline__ int crow(int r, int hi) { return (r & 3) + 8 * (r >> 2) + 4 * hi; }
#define MFMA32(a, b, c) __builtin_amdgcn_mfma_f32_32x32x16_bf16((a), (b), (c), 0, 0, 0)
__device__ __forceinline__ void attn_phase(LAS unsigned char* lds, bf16* Q, const bf16* Kg, const bf16* Vt, const float* sink) {
    int tid_ = threadIdx.x; asm volatile("" : "+v"(tid_));
    const int tid = tid_, lane = tid & 63, wid = __builtin_amdgcn_readfirstlane(tid >> 6), i32 = lane & 31, hi = lane >> 5;
    for (int u = blockIdx.x; u < BATCH * 16 * NKV; u += gridDim.x) {
        const int kvh = u & 3, blk = (u >> 2) & 15, b = u >> 6;
        const int tlo = blk == 0 ? 128 : 0, thi = blk == 15 ? 256 : 384;
        const long tok0 = (long)b * SEQ + blk * 128 - 128;
#pragma unroll
        for (int j = 0; j < 6; ++j) { const int id = tid + 512 * j, t = id >> 3, c = id & 7;
            if (t >= tlo && t < thi) { const u32x4 v = *(const u32x4*)(Kg + (tok0 + t) * 256 + kvh * 64 + c * 8); *(LAS u32x4*)(lds + LDS_K + t * KSTR + c * 16) = v; } }
#pragma unroll
        for (int j = 0; j < 6; ++j) { const int id = tid + 512 * j, d = id / 48, ch = id % 48, t = ch * 8;
            if (t >= tlo && t < thi) { const u32x4 v = *(const u32x4*)(Vt + (size_t)(kvh * 64 + d) * MTOK + tok0 + t);
                LAS u32x2* p = (LAS u32x2*)(lds + LDS_V + d * VSTR + ch * 16); p[0] = (u32x2){v.x, v.y}; p[1] = (u32x2){v.z, v.w}; } }
        __syncthreads();
        const int g = wid >> 1, r0 = (wid & 1) * 64, h = kvh * 4 + g;
        const long qrow0 = (long)b * SEQ + blk * 128 + r0;
        bf16x8 qf[2][4];
#pragma unroll
        for (int qt = 0; qt < 2; ++qt)
#pragma unroll
            for (int dc = 0; dc < 4; ++dc) qf[qt][dc] = *(const bf16x8*)(Q + (qrow0 + qt * 32 + i32) * 1024 + h * 64 + dc * 16 + hi * 8);
        f32x16 o[2][2];
#pragma unroll
        for (int a = 0; a < 2; ++a)
#pragma unroll
            for (int c = 0; c < 2; ++c)
#pragma unroll
                for (int r = 0; r < 16; ++r) o[a][c][r] = 0.f;
        const float sink2 = sink[h] * LOG2E;
        float mrun[2] = {sink2, sink2}, lrun[2] = {0.f, 0.f};
        const int ktlo = (tlo > r0 ? tlo : r0) >> 5, kthi = (thi < r0 + 320 ? thi : r0 + 320) >> 5;
        for (int kt = ktlo; kt < kthi; ++kt) {
            const int t0 = kt * 32;
            f32x16 s[2];
#pragma unroll
            for (int r = 0; r < 16; ++r) { s[0][r] = 0.f; s[1][r] = 0.f; }
#pragma unroll
            for (int dc = 0; dc < 4; ++dc) { const bf16x8 kf = *(const LAS bf16x8*)(lds + LDS_K + (t0 + i32) * KSTR + dc * 32 + hi * 16);
                s[0] = MFMA32(kf, qf[0][dc], s[0]); s[1] = MFMA32(kf, qf[1][dc], s[1]); }
            bf16x8 vf[2][2];
#pragma unroll
            for (int dt = 0; dt < 2; ++dt)
#pragma unroll
                for (int c = 0; c < 2; ++c) { const LAS unsigned char* vp = lds + LDS_V + (dt * 32 + i32) * VSTR + (t0 + 16 * c + 4 * hi) * 2;
                    const u32x2 lo = *(const LAS u32x2*)vp, hh = *(const LAS u32x2*)(vp + 16); vf[dt][c] = __builtin_bit_cast(bf16x8, (u32x4){lo.x, lo.y, hh.x, hh.y}); }
            const bool full = (t0 >= r0 + 63) && (t0 + 31 <= r0 + 256);
            if (!full) {
#pragma unroll
                for (int qt = 0; qt < 2; ++qt) { const int rq = r0 + qt * 32 + i32;
#pragma unroll
                    for (int r = 0; r < 16; ++r) { const int t = t0 + crow(r, hi); if (t < rq || t > rq + 256) s[qt][r] = -1e30f; } }
            }
#pragma unroll
            for (int qt = 0; qt < 2; ++qt) {
                float mx = s[qt][0];
#pragma unroll
                for (int r = 1; r < 16; ++r) mx = fmaxf(mx, s[qt][r]);
                mx = fmaxf(mx, __shfl_xor(mx, 32));
                const float mn = fmaxf(mrun[qt], mx), alpha = __builtin_amdgcn_exp2f(mrun[qt] - mn);
                mrun[qt] = mn; float ls = 0.f;
#pragma unroll
                for (int r = 0; r < 16; ++r) { const float p = __builtin_amdgcn_exp2f(s[qt][r] - mn); s[qt][r] = p; ls += p; }
                lrun[qt] = lrun[qt] * alpha + ls;
#pragma unroll
                for (int r = 0; r < 16; ++r) { o[qt][0][r] *= alpha; o[qt][1][r] *= alpha; }
                u32x4 p0, p1;
                p0.x = pg8::cvt_pk_bf16(s[qt][0], s[qt][1]); p0.y = pg8::cvt_pk_bf16(s[qt][2], s[qt][3]); p0.z = pg8::cvt_pk_bf16(s[qt][4], s[qt][5]); p0.w = pg8::cvt_pk_bf16(s[qt][6], s[qt][7]);
                p1.x = pg8::cvt_pk_bf16(s[qt][8], s[qt][9]); p1.y = pg8::cvt_pk_bf16(s[qt][10], s[qt][11]); p1.z = pg8::cvt_pk_bf16(s[qt][12], s[qt][13]); p1.w = pg8::cvt_pk_bf16(s[qt][14], s[qt][15]);
                const bf16x8 pf0 = __builtin_bit_cast(bf16x8, p0), pf1 = __builtin_bit_cast(bf16x8, p1);
#pragma unroll
                for (int dt = 0; dt < 2; ++dt) { o[qt][dt] = MFMA32(vf[dt][0], pf0, o[qt][dt]); o[qt][dt] = MFMA32(vf[dt][1], pf1, o[qt][dt]); }
            }
        }
#pragma unroll
        for (int qt = 0; qt < 2; ++qt) {
            const float lt = lrun[qt] + __shfl_xor(lrun[qt], 32) + __builtin_amdgcn_exp2f(sink2 - mrun[qt]);
            const float inv = 1.0f / lt;
            bf16* orow = Q + (qrow0 + qt * 32 + i32) * 1024 + h * 64 + 4 * hi;
#pragma unroll
            for (int dt = 0; dt < 2; ++dt)
#pragma unroll
                for (int r4 = 0; r4 < 4; ++r4) { u32x2 w; w.x = pg8::cvt_pk_bf16(o[qt][dt][4 * r4] * inv, o[qt][dt][4 * r4 + 1] * inv); w.y = pg8::cvt_pk_bf16(o[qt][dt][4 * r4 + 2] * inv, o[qt][dt][4 * r4 + 3] * inv);
                    *(u32x2*)(orow + dt * 32 + 8 * r4) = w; }
        }
        __syncthreads();
    }
}
}

__device__ __forceinline__ void row_pass(const float* rin, const bf16* y, const float* gpost, const float* gnext, float* rout, bf16* xn) {
    int tid_ = threadIdx.x; asm volatile("" : "+v"(tid_)); const int lane = tid_ & 63, wave = __builtin_amdgcn_readfirstlane(tid_ >> 6);
    const int gw = blockIdx.x * NWAVES + wave, NGW = gridDim.x * NWAVES;
    for (int row = gw; row < MTOK; row += NGW) {
        const size_t off = (size_t)row * DM + 4 * lane;
        f32x4 yv[4], hv[4]; float ss = 0.f;
#pragma unroll
        for (int j = 0; j < 4; ++j) { const u32x2 w = *(const u32x2*)(y + off + 256 * j);
            yv[j] = (f32x4){__uint_as_float(w.x << 16), __uint_as_float(w.x & 0xffff0000u), __uint_as_float(w.y << 16), __uint_as_float(w.y & 0xffff0000u)};
            ss += (yv[j][0] * yv[j][0] + yv[j][1] * yv[j][1]) + (yv[j][2] * yv[j][2] + yv[j][3] * yv[j][3]); }
        const float rstd = 1.0f / sqrtf(wave_sum(ss) * (1.0f / DM) + RMS_EPS);
        float s2 = 0.f;
#pragma unroll
        for (int j = 0; j < 4; ++j) { const f32x4 g = *(const f32x4*)(gpost + 4 * lane + 256 * j), r = *(const f32x4*)(rin + off + 256 * j);
            hv[j] = r + (yv[j] * rstd) * g; *(f32x4*)(rout + off + 256 * j) = hv[j];
            s2 += (hv[j][0] * hv[j][0] + hv[j][1] * hv[j][1]) + (hv[j][2] * hv[j][2] + hv[j][3] * hv[j][3]); }
        if (gnext) {
            const float rstd2 = 1.0f / sqrtf(wave_sum(s2) * (1.0f / DM) + RMS_EPS);
#pragma unroll
            for (int j = 0; j < 4; ++j) { const f32x4 g = *(const f32x4*)(gnext + 4 * lane + 256 * j); const f32x4 v = (hv[j] * rstd2) * g;
                u32x2 w; w.x = pk2(v[0], v[1]); w.y = pk2(v[2], v[3]); *(u32x2*)(xn + off + 256 * j) = w; }
        }
    }
}
__device__ __forceinline__ void norm_rows(const float* x, const float* g, bf16* xn) {
    int tid_ = threadIdx.x; asm volatile("" : "+v"(tid_)); const int lane = tid_ & 63, wave = __builtin_amdgcn_readfirstlane(tid_ >> 6);
    const int gw = blockIdx.x * NWAVES + wave, NGW = gridDim.x * NWAVES;
    for (int row = gw; row < MTOK; row += NGW) {
        const size_t off = (size_t)row * DM + 4 * lane;
        f32x4 v[4]; float ss = 0.f;
#pragma unroll
        for (int j = 0; j < 4; ++j) { v[j] = *(const f32x4*)(x + off + 256 * j); ss += (v[j][0] * v[j][0] + v[j][1] * v[j][1]) + (v[j][2] * v[j][2] + v[j][3] * v[j][3]); }
        const float rstd = 1.0f / sqrtf(wave_sum(ss) * (1.0f / DM) + RMS_EPS);
#pragma unroll
        for (int j = 0; j < 4; ++j) { const f32x4 gg = *(const f32x4*)(g + 4 * lane + 256 * j); const f32x4 o = (v[j] * rstd) * gg;
            u32x2 w; w.x = pk2(o[0], o[1]); w.y = pk2(o[2], o[3]); *(u32x2*)(xn + off + 256 * j) = w; }
    }
}

__device__ __forceinline__ int map_col(int mode, int n) {
    if (mode == 1) {
        if (n >= 1280) return n;
        const int p = n & 63, j = p >> 3, e = p & 7; return (n & ~63) + (e < 4 ? 4 * j + e : 32 + 4 * j + (e - 4));
    }
    if (mode == 2) {
        if (n >= 2048) return n - 2048;
        const int j = n >> 8, hsel = (n >> 7) & 1, i = n & 127; return 1024 + hsel * 1024 + 128 * j + i;
    }
    return n;
}
__device__ __forceinline__ void transpose_item(const float* W, int K, int N, bf16* WT, int mode, LAS float* scr, int item, int lane) {
    const int nblk = N / 32, kb = item / nblk, nb = item % nblk, k0 = 64 * kb, n0 = 32 * nb;
    const int src = map_col(mode, n0 + (lane & 31));
#pragma unroll 8
    for (int i = 0; i < 32; ++i) { const int kk = 2 * i + (lane >> 5); scr[kk * 33 + (lane & 31)] = W[(size_t)(k0 + kk) * N + src]; }
    asm volatile("s_waitcnt lgkmcnt(0)" ::: "memory");
    const int c = lane & 7;
#pragma unroll
    for (int j = 0; j < 4; ++j) { const int n = (lane >> 3) + 8 * j; const LAS float* s = scr + (8 * c) * 33 + n;
        u32x4 o; o.x = pk2(s[0 * 33], s[1 * 33]); o.y = pk2(s[2 * 33], s[3 * 33]); o.z = pk2(s[4 * 33], s[5 * 33]); o.w = pk2(s[6 * 33], s[7 * 33]);
        *(u32x4*)(WT + (size_t)(n0 + n) * K + k0 + 8 * c) = o; }
    asm volatile("s_waitcnt lgkmcnt(0)" ::: "memory");
}
__device__ const float INV_FREQ[32] = {1.000000000e+00f, 7.498942614e-01f, 5.623413324e-01f, 4.216965139e-01f, 3.162277639e-01f, 2.371373773e-01f, 1.778279394e-01f, 1.333521307e-01f, 1.000000015e-01f, 7.498941571e-02f, 5.623413250e-02f, 4.216965288e-02f, 3.162277490e-02f, 2.371373773e-02f, 1.778279431e-02f, 1.333521493e-02f, 9.999999776e-03f, 7.498941850e-03f, 5.623413250e-03f, 4.216964822e-03f, 3.162277630e-03f, 2.371373586e-03f, 1.778279431e-03f, 1.333521446e-03f, 1.000000047e-03f, 7.498942432e-04f, 5.623413017e-04f, 4.216965172e-04f, 3.162277571e-04f, 2.371373703e-04f, 1.778279402e-04f, 1.333521504e-04f};
__device__ __forceinline__ void sincos_f64(float angf, float& c, float& s) {
    const double a = (double)angf, k = __builtin_rint(a * 0.63661977236758134308);
    double r = __builtin_fma(-k, 1.57079632679489655800e+00, a); r = __builtin_fma(-k, 6.12323399573676603587e-17, r);
    const double r2 = r * r;
    double sp = -1.0 / 1307674368000.0; sp = sp * r2 + 1.0 / 6227020800.0; sp = sp * r2 - 1.0 / 39916800.0; sp = sp * r2 + 1.0 / 362880.0; sp = sp * r2 - 1.0 / 5040.0; sp = sp * r2 + 1.0 / 120.0; sp = sp * r2 - 1.0 / 6.0; sp = sp * r2 + 1.0;
    double cp = 1.0 / 20922789888000.0; cp = cp * r2 - 1.0 / 87178291200.0; cp = cp * r2 + 1.0 / 479001600.0; cp = cp * r2 - 1.0 / 3628800.0; cp = cp * r2 + 1.0 / 40320.0; cp = cp * r2 - 1.0 / 720.0; cp = cp * r2 + 1.0 / 24.0; cp = cp * r2 - 0.5; cp = cp * r2 + 1.0;
    const double sr = sp * r, cr = cp; const int q = (int)((long long)k & 3);
    const double cc = (q == 0) ? cr : (q == 1) ? -sr : (q == 2) ? -cr : sr;
    const double sv = (q == 0) ? sr : (q == 1) ? cr : (q == 2) ? -sr : -cr;
    c = (float)cc; s = (float)sv;
}

#ifndef PHASES
#define PHASES 0xffff
#endif
#define PH(k) ((PHASES >> (k)) & 1)
struct Args { const float* in[12]; float* out; unsigned char* ws; };

typedef const Args __attribute__((address_space(4)))* ArgsP;
#define PTRS ArgsP ap_ = (ArgsP)__builtin_amdgcn_kernarg_segment_ptr(); asm volatile("" : "+s"(ap_)); \
    unsigned char* ws = ap_->ws; (void)ws; \
    const float* x = ap_->in[0]; const int* positions = (const int*)ap_->in[1]; const float* w_qkv = ap_->in[2]; const float* sink = ap_->in[3]; const float* w_o = ap_->in[4]; \
    const float* w_in = ap_->in[5]; const float* conv_w = ap_->in[6]; const float* w_out = ap_->in[7]; const float* gains = ap_->in[8]; const float* w_gu = ap_->in[9]; \
    const float* ffn_cw = ap_->in[10]; const float* w_dn = ap_->in[11]; float* out = ap_->out; \
    bf16* Wqkv_t = (bf16*)(ws + WS_WQKV); bf16* Wo_t = (bf16*)(ws + WS_WO); bf16* Win_t = (bf16*)(ws + WS_WIN); bf16* Wout_t = (bf16*)(ws + WS_WOUT); \
    bf16* Wgu_t = (bf16*)(ws + WS_WGU); bf16* Wd_t = (bf16*)(ws + WS_WD); float* rcos = (float*)(ws + WS_ROPE); float* rsin = rcos + SEQ * 32; \
    bf16* XN = (bf16*)(ws + WS_XN); bf16* Y = (bf16*)(ws + WS_Y); bf16* GB = (bf16*)(ws + WS_G); bf16* ACT = (bf16*)(ws + WS_ACT); \
    bf16* QB = (bf16*)(ws + WS_Q); bf16* KB = (bf16*)(ws + WS_K); bf16* VT = (bf16*)(ws + WS_VT); bf16* PB = (bf16*)(ws + WS_P); bf16* Y2 = (bf16*)(ws + WS_Y2); \
    (void)x; (void)positions; (void)w_qkv; (void)sink; (void)w_o; (void)w_in; (void)conv_w; (void)w_out; (void)gains; (void)w_gu; (void)ffn_cw; (void)w_dn; (void)out; \
    (void)Wqkv_t; (void)Wo_t; (void)Win_t; (void)Wout_t; (void)Wgu_t; (void)Wd_t; (void)rcos; (void)rsin; (void)XN; (void)Y; (void)GB; (void)ACT; (void)QB; (void)KB; (void)VT; (void)PB; (void)Y2; \
    const int G = gridDim.x; (void)G

__global__ void __launch_bounds__(NWAVES * 64, 2) fwd_megakernel(Args args) {
    extern __shared__ __attribute__((aligned(16))) unsigned char lds_raw[];
    LAS unsigned char* lds = (LAS unsigned char*)lds_raw;
    cg::grid_group grid = cg::this_grid();
#define SYNC() grid.sync()

    if (PH(0)) {
        PTRS;
        int tid_ = threadIdx.x; asm volatile("" : "+v"(tid_)); const int tid = tid_, lane = tid & 63, wave = __builtin_amdgcn_readfirstlane(tid >> 6);
        LAS float* scr = (LAS float*)(lds + wave * 16384);
        const int gw = blockIdx.x * NWAVES + wave, NGW = G * NWAVES;
        constexpr int I_QKV = 16 * (NQKV / 32), I_O = 16 * 32, I_IN = 16 * 96, I_OUT = 16 * 32, I_GU = 16 * (2 * FF / 32), I_D = (FF / 64) * 32;
        constexpr int NITEMS = I_QKV + I_O + I_IN + I_OUT + 2 * I_GU + 2 * I_D;
        for (int it = gw; it < NITEMS; it += NGW) {
            int r = it;
            if (r < I_QKV) { transpose_item(w_qkv, DM, NQKV, Wqkv_t, 1, scr, r, lane); continue; } r -= I_QKV;
            if (r < I_O) { transpose_item(w_o, DM, DM, Wo_t, 0, scr, r, lane); continue; } r -= I_O;
            if (r < I_IN) { transpose_item(w_in, DM, 3 * DM, Win_t, 2, scr, r, lane); continue; } r -= I_IN;
            if (r < I_OUT) { transpose_item(w_out, DM, DM, Wout_t, 0, scr, r, lane); continue; } r -= I_OUT;
            if (r < I_GU) { transpose_item(w_gu, DM, 2 * FF, Wgu_t, 0, scr, r, lane); continue; } r -= I_GU;
            if (r < I_GU) { transpose_item(w_gu + (size_t)DM * 2 * FF, DM, 2 * FF, Wgu_t + (size_t)2 * FF * DM, 0, scr, r, lane); continue; } r -= I_GU;
            if (r < I_D) { transpose_item(w_dn, FF, DM, Wd_t, 0, scr, r, lane); continue; } r -= I_D;
            transpose_item(w_dn + (size_t)FF * DM, FF, DM, Wd_t + (size_t)DM * FF, 0, scr, r, lane);
        }
        for (int e = blockIdx.x * (NWAVES * 64) + tid; e < SEQ * 32; e += G * NWAVES * 64) {
            const int s = e >> 5, i = e & 31; const float ang = (float)positions[s] * INV_FREQ[i];
            float c, sn; sincos_f64(ang, c, sn); rcos[e] = c; rsin[e] = sn;
        }
        norm_rows(x, gains, XN);
    }
    SYNC();
    if (PH(1)) {
        PTRS;
        pg8::Gemm g{XN, Wqkv_t, MTOK, 1280, DM, Wqkv_t + (size_t)1280 * DM, XN}; pg8::StaticOrder S; S.init(MTOK, 1280, G, (int)blockIdx.x, MTOK / 256);
        pg8::EpiQKV E{QB, (long)((WS_K - WS_Q) / 2), (long)((WS_VT - WS_Q) / 2), rcos, rsin, 0.125f * LOG2E, MTOK};
        pg8::gemm_phase<pg8::EpiQKV, pg8::StaticOrder, true, true>(lds, g, S, E);
    }
    SYNC();
    if (PH(2)) { PTRS; att::attn_phase(lds, QB, KB, VT, sink); }
    SYNC();
    if (PH(3)) {
        PTRS;
        pg8::Gemm g{QB, Wo_t, MTOK, DM, DM, nullptr, nullptr}; pg8::StaticOrder S; S.init(MTOK, DM, G, (int)blockIdx.x);
        pg8::EpiStore E{Y, DM};
        pg8::gemm_phase<pg8::EpiStore, pg8::StaticOrder, true, true>(lds, g, S, E);
    }
    SYNC();
    if (PH(4)) { PTRS; row_pass(x, Y, gains + 1 * DM, gains + 2 * DM, out, XN); }
    SYNC();
#pragma unroll 1
    for (int layer = 0; layer < 2; ++layer) {
        if (PH(5) && layer == 1) {
            if (PH(7)) {
                PTRS;
                pg8::Gemm g{XN, Win_t, MTOK, 2048, DM, nullptr, nullptr}; pg8::StaticOrder S; S.init(MTOK, 2048, G, (int)blockIdx.x);
                pg8::EpiCX E{PB};
                pg8::gemm_phase<pg8::EpiCX, pg8::StaticOrder, true, true>(lds, g, S, E);
            }
            SYNC();
            if (PH(8)) {
                PTRS;
                pg8::Gemm g{XN, Win_t + (size_t)2048 * DM, MTOK, DM, DM, nullptr, nullptr}; pg8::StaticOrder S; S.init(MTOK, DM, G, (int)blockIdx.x);
                pg8::EpiConv<0> E{PB, conv_w, Y2, DM};
                pg8::gemm_phase<pg8::EpiConv<0>, pg8::StaticOrder, true, true>(lds, g, S, E);
            }
            SYNC();
            if (PH(9)) {
                PTRS;
                pg8::Gemm g{Y2, Wout_t, MTOK, DM, DM, nullptr, nullptr}; pg8::StaticOrder S; S.init(MTOK, DM, G, (int)blockIdx.x);
                pg8::EpiStore E{Y, DM};
                pg8::gemm_phase<pg8::EpiStore, pg8::StaticOrder, true, true>(lds, g, S, E);
            }
            SYNC();
            { PTRS; row_pass(out, Y, gains + 5 * DM, gains + 6 * DM, out, XN); }
            SYNC();
        }
        if (!PH(6)) continue;
        if (PH(10)) {
            PTRS; const bf16* Wg = Wgu_t + (size_t)layer * 2 * FF * DM;
            pg8::Gemm g{XN, Wg, MTOK, FF, DM, nullptr, nullptr}; pg8::StaticOrder S; S.init(MTOK, FF, G, (int)blockIdx.x);
            pg8::EpiStore E{GB, FF};
            pg8::gemm_phase<pg8::EpiStore, pg8::StaticOrder, true, true>(lds, g, S, E);
        }
        SYNC();
        if (PH(11)) {
            PTRS; const bf16* Wg = Wgu_t + (size_t)layer * 2 * FF * DM;
            pg8::Gemm g{XN, Wg + (size_t)FF * DM, MTOK, FF, DM, nullptr, nullptr}; pg8::StaticOrder S; S.init(MTOK, FF, G, (int)blockIdx.x);
            pg8::EpiConv<1> E{GB, ffn_cw + (size_t)layer * 3 * FF, ACT, FF};
            pg8::gemm_phase<pg8::EpiConv<1>, pg8::StaticOrder, true, true>(lds, g, S, E);
        }
        SYNC();
        if (PH(12)) {
            PTRS; const bf16* Wd = Wd_t + (size_t)layer * DM * FF;
            pg8::Gemm g{ACT, Wd, MTOK, DM, FF, nullptr, nullptr}; pg8::StaticOrder S; S.init(MTOK, DM, G, (int)blockIdx.x);
            pg8::EpiStore E{Y, DM};
            pg8::gemm_phase<pg8::EpiStore, pg8::StaticOrder, true, true>(lds, g, S, E);
        }
        SYNC();
        { PTRS; row_pass(out, Y, gains + (layer * 4 + 3) * DM, layer == 0 ? gains + 4 * DM : nullptr, out, XN); }
        if (layer == 0) SYNC();
    }
}

extern "C" void kernel_launch(void* const* d_in, const int* in_sizes, int n_in, void* d_out, int out_size, void* d_ws, size_t ws_size, hipStream_t stream) {
    static int grid = 0;
    if (grid == 0) {
        if (n_in != 12 || in_sizes[0] != MTOK * DM || out_size != MTOK * DM || ws_size < WS_END) { fprintf(stderr, "kernel_launch: unexpected shapes / workspace (n_in %d, in0 %d, out %d, ws %zu)\n", n_in, n_in > 0 ? in_sizes[0] : -1, out_size, ws_size); grid = -1; return; }
        int dev = 0, cus = 0, per_cu = 0;
        hipGetDevice(&dev); hipDeviceGetAttribute(&cus, hipDeviceAttributeMultiprocessorCount, dev);
        if (hipFuncSetAttribute((const void*)fwd_megakernel, hipFuncAttributeMaxDynamicSharedMemorySize, LDS_BYTES) != hipSuccess) { fprintf(stderr, "kernel_launch: hipFuncSetAttribute failed\n"); grid = -1; return; }
        if (hipOccupancyMaxActiveBlocksPerMultiprocessor(&per_cu, (const void*)fwd_megakernel, NWAVES * 64, LDS_BYTES) != hipSuccess || per_cu < 1) { fprintf(stderr, "kernel_launch: occupancy query says %d\n", per_cu); per_cu = 1; }
        (void)hipGetLastError();
        grid = cus * per_cu;
    }
    if (grid < 0) return;
    Args a{};
    for (int i = 0; i < 12; ++i) a.in[i] = (const float*)d_in[i];
    a.out = (float*)d_out; a.ws = (unsigned char*)d_ws;
    void* kargs[] = {&a};
    hipError_t e = hipLaunchCooperativeKernel((const void*)fwd_megakernel, dim3(grid), dim3(NWAVES * 64), kargs, LDS_BYTES, stream);
    if (e != hipSuccess) fprintf(stderr, "kernel_launch: cooperative launch failed: %s (grid %d)\n", hipGetErrorString(e), grid);
}
```

```cpp
#include <hip/hip_runtime.h>
#include <hip/hip_cooperative_groups.h>
#include <cstdio>
#include <cstdint>
namespace cg = cooperative_groups;
namespace pg8 {
#define PG8_LAS __attribute__((address_space(3)))
typedef unsigned short bf16_t;
typedef short bf16x8 __attribute__((ext_vector_type(8)));
typedef float f32x4 __attribute__((ext_vector_type(4)));
typedef unsigned u32x4 __attribute__((ext_vector_type(4)));
constexpr int BM = 256, BK = 64, HALF = 128, HTB = HALF * BK * 2  , STAGE_BYTES = 8 * HTB, NXCD = 8, WGM = 8;

__host__ __device__ __forceinline__ int lds_byte(int r, int c) { const int st = (r >> 4) * 2 + (c >> 5), rr = r & 15, cc = c & 31, ob = rr * 64 + cc * 2; return st * 1024 + (ob ^ (((ob >> 9) & 1) << 5)); }
__host__ __device__ __forceinline__ void stage_rc(int b, int& R, int& C) { const int st = b / 1024, sb = b % 1024, swz = sb ^ (((sb >> 9) & 1) << 5); R = (st >> 1) * 16 + swz / 64; C = (st & 1) * 32 + (swz % 64) / 2; }
__host__ __device__ __forceinline__ int perm32(int rho) { const int n = rho >> 4, i = rho & 15; return 8 * (i >> 2) + 4 * n + (i & 3); }

typedef unsigned u32x2 __attribute__((ext_vector_type(2)));
struct Unit { int pm, pn, w; };
struct Gemm { const bf16_t* A; const bf16_t* Bt; int M, N, K; const bf16_t* A2; const bf16_t* Bt2; };

struct StaticOrder {
    int nM, nN, nwg, G, c, n2;
    __host__ __device__ void init(int M, int N, int G_, int c_, int n2_ = 0) { nM = M / BM; nN = N / BM; nwg = nM * nN; G = G_; c = c_; n2 = n2_; }
    __host__ __device__ bool next(int i, Unit& u) const {
        const long L = (long)i * G + c; if (L >= nwg + n2) return false;
        if (L >= nwg) { u.w = 1; u.pm = 0; u.pn = (int)(L - nwg); return true; }
        u.w = 0;
        int wgid = (int)L; { const int q = nwg / NXCD, r = nwg % NXCD, xcd = wgid % NXCD, off = wgid / NXCD; wgid = (xcd < r ? xcd * (q + 1) : r * (q + 1) + (xcd - r) * q) + off; }
        const int nig = WGM * nN, gid = wgid / nig, fm = gid * WGM, gsz = (nM - fm) < WGM ? (nM - fm) : WGM;
        u.pm = fm + ((wgid % nig) % gsz); u.pn = (wgid % nig) / gsz; return true;
    }
    __device__ __forceinline__ void a_ready(const Unit&) const {}
    __device__ __forceinline__ void done(const Unit&) const {}
};

__device__ __forceinline__ unsigned cvt_pk_bf16(float lo, float hi) { unsigned r; asm volatile("v_cvt_pk_bf16_f32 %0, %1, %2" : "=v"(r) : "v"(lo), "v"(hi)); return r; }
__device__ __forceinline__ u32x4 pack8(const f32x4 a, const f32x4 b) { u32x4 w; w.x = cvt_pk_bf16(a[0], a[1]); w.y = cvt_pk_bf16(a[2], a[3]); w.z = cvt_pk_bf16(b[0], b[1]); w.w = cvt_pk_bf16(b[2], b[3]); return w; }
__device__ __forceinline__ f32x4 bf_lo4(const u32x4 w) { return (f32x4){__uint_as_float(w.x << 16), __uint_as_float(w.x & 0xffff0000u), __uint_as_float(w.y << 16), __uint_as_float(w.y & 0xffff0000u)}; }
__device__ __forceinline__ f32x4 bf_hi4(const u32x4 w) { return (f32x4){__uint_as_float(w.z << 16), __uint_as_float(w.z & 0xffff0000u), __uint_as_float(w.w << 16), __uint_as_float(w.w & 0xffff0000u)}; }

struct EpiStore {
    static constexpr bool PERM = true, AFTER_DRAIN = false;
    bf16_t* O; int ldc;
    __device__ __forceinline__ void operator()(const f32x4 (&acc)[2][2][4][2], const Unit& u, int wr, int wc, int fr, int fq) const {
        const int row0 = u.pm * BM + wr * 64 + fr, col0 = u.pn * BM + wc * 32 + 8 * fq;
#pragma unroll
        for (int ai = 0; ai < 2; ++ai)
#pragma unroll
            for (int m = 0; m < 4; ++m) { bf16_t* rowp = O + (size_t)(row0 + ai * HALF + m * 16) * ldc + col0;
#pragma unroll
                for (int bj = 0; bj < 2; ++bj) *(u32x4*)(rowp + bj * HALF) = pack8(acc[ai][bj][m][0], acc[ai][bj][m][1]); }
    }
};

struct EpiQKV {
    static constexpr bool PERM = true, AFTER_DRAIN = false;
    bf16_t* Q; long offK, offV; const float* rcos; const float* rsin; float qscale; int mtok;
    __device__ __forceinline__ void operator()(const f32x4 (&acc)[2][2][4][2], const Unit& u, int wr, int wc, int fr, int fq) const {
        const bool isv = u.w != 0, isq = u.pn < 4;
        bf16_t* base = Q + (isv ? offV : (isq ? 0L : offK)); const int ldc = isv ? mtok : (isq ? 1024 : 256), colt = (isv || isq) ? u.pn * BM : 0; const float sc = (!isv && isq) ? qscale : 1.0f;
        const int i0 = 4 * ((wc & 1) * 4 + fq);
#pragma unroll
        for (int ai = 0; ai < 2; ++ai)
#pragma unroll
            for (int m = 0; m < 4; ++m) {
                const int row = u.pm * BM + ai * HALF + wr * 64 + m * 16 + fr, s = row & 2047;
                f32x4 c = (f32x4){1.f, 1.f, 1.f, 1.f}, sn = (f32x4){0.f, 0.f, 0.f, 0.f};
                if (!isv) { c = *(const f32x4*)(rcos + s * 32 + i0) * sc; sn = *(const f32x4*)(rsin + s * 32 + i0) * sc; }
                bf16_t* rowp = base + (size_t)row * ldc + colt + wc * 32 + 8 * fq;
#pragma unroll
                for (int bj = 0; bj < 2; ++bj) { const f32x4 x1 = acc[ai][bj][m][0], x2 = acc[ai][bj][m][1];
                    *(u32x4*)(rowp + bj * HALF) = pack8(x1 * c - x2 * sn, x2 * c + x1 * sn); }
                if (m & 1) asm volatile("" ::: "memory");
            }
    }
};

struct EpiCX {
    static constexpr bool PERM = true, AFTER_DRAIN = false;
    bf16_t* P;
    __device__ __forceinline__ void operator()(const f32x4 (&acc)[2][2][4][2], const Unit& u, int wr, int wc, int fr, int fq) const {
        const int row0 = u.pm * BM + wr * 64 + fr, col0 = u.pn * HALF + wc * 32 + 8 * fq;
#pragma unroll
        for (int ai = 0; ai < 2; ++ai)
#pragma unroll
            for (int m = 0; m < 4; ++m)
                *(u32x4*)(P + (size_t)(row0 + ai * HALF + m * 16) * 1024 + col0) = pack8(acc[ai][0][m][0] * acc[ai][1][m][0], acc[ai][0][m][1] * acc[ai][1][m][1]);
    }
};

template <int MODE> struct EpiConv {
    static constexpr bool PERM = true, AFTER_DRAIN = false;
    const bf16_t* G; const float* cw; bf16_t* O; int ldc;
    __device__ __forceinline__ void operator()(const f32x4 (&acc)[2][2][4][2], const Unit& u, int wr, int wc, int fr, int fq) const {
        const int row0 = u.pm * BM + wr * 64 + fr;
#pragma unroll
        for (int bj = 0; bj < 2; ++bj) {
            const int col = u.pn * BM + bj * HALF + wc * 32 + 8 * fq;
            const f32x4 w0a = *(const f32x4*)(cw + col), w0b = *(const f32x4*)(cw + col + 4);
            const f32x4 w1a = *(const f32x4*)(cw + ldc + col), w1b = *(const f32x4*)(cw + ldc + col + 4);
            const f32x4 w2a = *(const f32x4*)(cw + 2 * ldc + col), w2b = *(const f32x4*)(cw + 2 * ldc + col + 4);
#pragma unroll
            for (int ai = 0; ai < 2; ++ai)
#pragma unroll
                for (int m = 0; m < 4; ++m) {
                    const int row = row0 + ai * HALF + m * 16, s = row & 2047;
                    const bf16_t* gp = G + (size_t)row * ldc + col;
                    const u32x4 zc = *(const u32x4*)gp;
                    u32x4 zp = (u32x4){0u, 0u, 0u, 0u}, zn = (u32x4){0u, 0u, 0u, 0u};
                    if (s > 0) zp = *(const u32x4*)(gp - ldc);
                    if (s < 2047) zn = *(const u32x4*)(gp + ldc);
                    f32x4 za = w0a * bf_lo4(zp) + w1a * bf_lo4(zc) + w2a * bf_lo4(zn);
                    f32x4 zb = w0b * bf_hi4(zp) + w1b * bf_hi4(zc) + w2b * bf_hi4(zn);
                    f32x4 oa, ob;
                    if (MODE == 0) { oa = acc[ai][bj][m][0] * za; ob = acc[ai][bj][m][1] * zb; }
                    else {
#pragma unroll
                        for (int e = 0; e < 4; ++e) {
                            oa[e] = za[e] * __builtin_amdgcn_rcpf(1.0f + __builtin_amdgcn_exp2f(za[e] * -1.4426950408889634f)) * acc[ai][bj][m][0][e];
                            ob[e] = zb[e] * __builtin_amdgcn_rcpf(1.0f + __builtin_amdgcn_exp2f(zb[e] * -1.4426950408889634f)) * acc[ai][bj][m][1][e]; }
                    }
                    *(u32x4*)(O + (size_t)row * ldc + col) = pack8(oa, ob);
                    if (m & 1) asm volatile("" ::: "memory");
                }
        }
    }
};

template <class Epi, class Sched, bool ALIGN_EPI = false, bool SP2 = false>
__device__ __forceinline__ void gemm_phase(PG8_LAS unsigned char* lds, const Gemm g, const Sched& S, const Epi& E) {
    int tid_ = threadIdx.x; asm volatile("" : "+v"(tid_));
    const int tid = tid_, wid = __builtin_amdgcn_readfirstlane(tid >> 6), lane = tid & 63, wr = wid >> 2, wc = wid & 3, fr = lane & 15, fq = lane >> 4;
    const int K = g.K, nt = K / BK;
    unsigned voffA[2], voffB[2];
#pragma unroll
    for (int i = 0; i < 2; ++i) { int R, C; stage_rc(tid * 16 + i * 8192, R, C); const int Rb = Epi::PERM ? ((R & ~31) + perm32(R & 31)) : R;
        voffA[i] = (unsigned)(R * K + C) * 2u; voffB[i] = (unsigned)(Rb * K + C) * 2u; }
    const size_t kstep = (size_t)(BK * 2);
    const size_t hstep = (size_t)HALF * K * 2;
    const size_t tstep = 2 * hstep;
    const unsigned ldsw = (unsigned)wid * 1024u;
    const int aoff = lds_byte(wr * 64 + fr, fq * 8), boff = lds_byte(wc * 32 + fr, fq * 8);
#define PG8_SA(b, h) (((b) * 2 + (h)) * HTB)
#define PG8_SB(b, h) ((4 + (b) * 2 + (h)) * HTB)
#define PG8_STAGE(bufoff, gbase, voff) do { _Pragma("unroll") for (int _i = 0; _i < 2; ++_i) \
        __builtin_amdgcn_global_load_lds((const unsigned*)((const char*)(gbase) + (voff)[_i]), (PG8_LAS unsigned*)(lds + (bufoff) + ldsw + _i * 8192), 16, 0, 0); } while (0)
#define PG8_LDA(dst, b, h) do { _Pragma("unroll") for (int m = 0; m < 4; ++m) _Pragma("unroll") for (int k = 0; k < 2; ++k) dst[m][k] = *(const PG8_LAS bf16x8*)(lds + PG8_SA(b, h) + aoff + m * 2048 + k * 1024); } while (0)
#define PG8_LDB(dst, b, h) do { _Pragma("unroll") for (int n = 0; n < 2; ++n) _Pragma("unroll") for (int k = 0; k < 2; ++k) dst[n][k] = *(const PG8_LAS bf16x8*)(lds + PG8_SB(b, h) + boff + n * 2048 + k * 1024); } while (0)
#define PG8_MMA(ai, bj, At, Bt) do { __builtin_amdgcn_s_setprio(1); _Pragma("unroll") for (int m = 0; m < 4; ++m) _Pragma("unroll") for (int n = 0; n < 2; ++n) _Pragma("unroll") for (int k = 0; k < 2; ++k) \
        acc[ai][bj][m][n] = __builtin_amdgcn_mfma_f32_16x16x32_bf16(Bt[n][k], At[m][k], acc[ai][bj][m][n], 0, 0, 0); __builtin_amdgcn_s_setprio(0); } while (0)
#define PG8_WAIT_V(n) asm volatile("s_waitcnt vmcnt(" #n ")" ::: "memory")
#define PG8_WAIT_L(n) asm volatile("s_waitcnt lgkmcnt(" #n ")" ::: "memory")
#define PG8_BAR __builtin_amdgcn_s_barrier()
#define PG8_SCHED __builtin_amdgcn_sched_barrier(0)
    Unit cur, nxt; int ui = 0;
    if (!S.next(0, cur)) return;
    f32x4 acc[2][2][4][2];
#pragma unroll
    for (int a = 0; a < 2; ++a)
#pragma unroll
        for (int b = 0; b < 2; ++b)
#pragma unroll
            for (int m = 0; m < 4; ++m)
#pragma unroll
                for (int n = 0; n < 2; ++n) acc[a][b][m][n] = (f32x4){0.f, 0.f, 0.f, 0.f};
    bf16x8 At[4][2], B0[2][2], B1[2][2];
    const char* cA = (const char*)(cur.w ? g.A2 : g.A) + (size_t)cur.pm * tstep; const char* cB = (const char*)(cur.w ? g.Bt2 : g.Bt) + (size_t)cur.pn * tstep;
    S.a_ready(cur);
    if constexpr (SP2) {
        PG8_STAGE(PG8_SB(0, 0), cB, voffB); PG8_STAGE(PG8_SB(0, 1), cB + hstep, voffB); PG8_STAGE(PG8_SA(0, 0), cA, voffA); PG8_STAGE(PG8_SA(0, 1), cA + hstep, voffA);
        if (wr == 1) PG8_BAR;
        PG8_WAIT_V(2); PG8_BAR;
        PG8_STAGE(PG8_SB(1, 0), cB + kstep, voffB); PG8_STAGE(PG8_SA(1, 0), cA + kstep, voffA); PG8_STAGE(PG8_SB(1, 1), cB + hstep + kstep, voffB);
        PG8_WAIT_V(6); PG8_BAR;
    } else {
        PG8_STAGE(PG8_SB(0, 0), cB, voffB); PG8_STAGE(PG8_SA(0, 0), cA, voffA); PG8_STAGE(PG8_SB(0, 1), cB + hstep, voffB); PG8_STAGE(PG8_SA(0, 1), cA + hstep, voffA);
        if (wr == 1) PG8_BAR;
        PG8_WAIT_V(4); PG8_BAR;
        PG8_STAGE(PG8_SB(1, 0), cB + kstep, voffB); PG8_STAGE(PG8_SA(1, 0), cA + kstep, voffA); PG8_STAGE(PG8_SB(1, 1), cB + hstep + kstep, voffB);
        PG8_WAIT_V(6); PG8_BAR;
    }
    for (;;) {
        const bool has_next = S.next(ui + 1, nxt);
        const char* nA = has_next ? (const char*)(nxt.w ? g.A2 : g.A) + (size_t)nxt.pm * tstep : cA; const char* nB = has_next ? (const char*)(nxt.w ? g.Bt2 : g.Bt) + (size_t)nxt.pn * tstep : cB;
        for (int t = 0; t < nt; t += 2) {
            const bool last = (t == nt - 2);
            const char* a1 = cA + (size_t)(t + 1) * kstep;
            const char* a2 = last ? nA : cA + (size_t)(t + 2) * kstep; const char* b2 = last ? nB : cB + (size_t)(t + 2) * kstep;
            const char* a3 = a2 + kstep; const char* b3 = b2 + kstep;
            if (last && has_next) S.a_ready(nxt);
            if constexpr (SP2) {
            PG8_LDB(B0, 0, 0); PG8_LDB(B1, 0, 1); PG8_SCHED; PG8_LDA(At, 0, 0); PG8_STAGE(PG8_SA(1, 1), a1 + hstep, voffA);
            PG8_WAIT_V(8); PG8_WAIT_L(0); PG8_BAR; PG8_MMA(0, 0, At, B0); PG8_MMA(0, 1, At, B1); PG8_BAR; PG8_SCHED;
            PG8_LDA(At, 0, 1); PG8_STAGE(PG8_SB(0, 0), b2, voffB); PG8_STAGE(PG8_SB(0, 1), b2 + hstep, voffB); PG8_STAGE(PG8_SA(0, 0), a2, voffA);
            PG8_WAIT_V(8); PG8_WAIT_L(0); PG8_BAR; PG8_MMA(1, 0, At, B0); PG8_MMA(1, 1, At, B1); PG8_BAR; PG8_SCHED;
            PG8_LDB(B0, 1, 0); PG8_LDB(B1, 1, 1); PG8_SCHED; PG8_LDA(At, 1, 0); PG8_STAGE(PG8_SA(0, 1), a2 + hstep, voffA);
            PG8_WAIT_V(8); PG8_WAIT_L(0); PG8_BAR; PG8_MMA(0, 0, At, B0); PG8_MMA(0, 1, At, B1); PG8_BAR; PG8_SCHED;
            PG8_LDA(At, 1, 1); PG8_STAGE(PG8_SB(1, 0), b3, voffB); PG8_STAGE(PG8_SB(1, 1), b3 + hstep, voffB); PG8_STAGE(PG8_SA(1, 0), a3, voffA);
            PG8_WAIT_V(8); PG8_WAIT_L(0); PG8_BAR; PG8_MMA(1, 0, At, B0); PG8_MMA(1, 1, At, B1); PG8_BAR; PG8_SCHED;
            } else {
            PG8_LDB(B0, 0, 0); PG8_SCHED; PG8_LDA(At, 0, 0); PG8_STAGE(PG8_SA(1, 1), a1 + hstep, voffA);
            PG8_WAIT_L(8); PG8_BAR; PG8_WAIT_L(0); PG8_MMA(0, 0, At, B0); PG8_BAR; PG8_SCHED;
            PG8_LDB(B1, 0, 1); PG8_STAGE(PG8_SB(0, 0), b2, voffB);
            PG8_BAR; PG8_WAIT_L(0); PG8_MMA(0, 1, At, B1); PG8_BAR;
            PG8_LDA(At, 0, 1); PG8_STAGE(PG8_SA(0, 0), a2, voffA);
            PG8_BAR; PG8_WAIT_L(0); PG8_MMA(1, 0, At, B0); PG8_BAR; PG8_SCHED;
            PG8_STAGE(PG8_SB(0, 1), b2 + hstep, voffB);
            PG8_WAIT_V(6); PG8_BAR; PG8_MMA(1, 1, At, B1); PG8_BAR;
            PG8_LDB(B0, 1, 0); PG8_SCHED; PG8_LDA(At, 1, 0); PG8_STAGE(PG8_SA(0, 1), a2 + hstep, voffA);
            PG8_WAIT_L(8); PG8_BAR; PG8_WAIT_L(0); PG8_MMA(0, 0, At, B0); PG8_BAR; PG8_SCHED;
            PG8_LDB(B1, 1, 1); PG8_STAGE(PG8_SB(1, 0), b3, voffB);
            PG8_BAR; PG8_WAIT_L(0); PG8_MMA(0, 1, At, B1); PG8_BAR;
            PG8_LDA(At, 1, 1); PG8_STAGE(PG8_SA(1, 0), a3, voffA);
            PG8_BAR; PG8_WAIT_L(0); PG8_MMA(1, 0, At, B0); PG8_BAR; PG8_SCHED;
            PG8_STAGE(PG8_SB(1, 1), b3 + hstep, voffB);
            PG8_WAIT_V(6); PG8_BAR; PG8_MMA(1, 1, At, B1); PG8_BAR;
            }
        }
        if constexpr (ALIGN_EPI) { if (wr == 0) PG8_BAR; }
        if constexpr (!Epi::AFTER_DRAIN) { E(acc, cur, wr, wc, fr, fq); S.done(cur); }
        if (!has_next) break;
#pragma unroll
        for (int a = 0; a < 2; ++a)
#pragma unroll
            for (int b = 0; b < 2; ++b)
#pragma unroll
                for (int m = 0; m < 4; ++m)
#pragma unroll
                    for (int n = 0; n < 2; ++n) acc[a][b][m][n] = (f32x4){0.f, 0.f, 0.f, 0.f};
        cur = nxt; cA = nA; cB = nB; ++ui;
        if constexpr (ALIGN_EPI) { if (wr == 1) PG8_BAR; }
    }
    PG8_WAIT_V(0);
    if constexpr (!ALIGN_EPI) { if (wr == 0) PG8_BAR; }
    PG8_BAR;
    if constexpr (Epi::AFTER_DRAIN) { E.fused(acc, cur, wr, wc, fr, fq, lds, wid, lane); S.done(cur); }
#undef PG8_SA
#undef PG8_SB
#undef PG8_STAGE
#undef PG8_LDA
#undef PG8_LDB
#undef PG8_MMA
#undef PG8_WAIT_V
#undef PG8_WAIT_L
#undef PG8_BAR
#undef PG8_SCHED
}
}

constexpr int BATCH = 16, SEQ = 2048, DM = 1024, MTOK = BATCH * SEQ, NQKV = 1536, FF = 2816, NH = 16, NKV = 4, HD = 64;
constexpr float RMS_EPS = 1e-6f, LOG2E = 1.4426950408889634f;
constexpr int NWAVES = 8;
#define LAS __attribute__((address_space(3)))
typedef unsigned short bf16;
typedef float f32x4 __attribute__((ext_vector_type(4)));
typedef float f32x16 __attribute__((ext_vector_type(16)));
typedef unsigned u32x4 __attribute__((ext_vector_type(4)));
typedef unsigned u32x2 __attribute__((ext_vector_type(2)));
typedef short bf16x8 __attribute__((ext_vector_type(8)));

constexpr size_t MiB = 1u << 20;
constexpr size_t WS_WQKV = 0, WS_WO = 3 * MiB, WS_WIN = 5 * MiB, WS_WOUT = 11 * MiB, WS_WGU = 13 * MiB  , WS_WD = 35 * MiB  ;
constexpr size_t WS_ROPE = 46 * MiB;
constexpr size_t WS_CTL = 47 * MiB;
constexpr size_t WS_XN = 48 * MiB;
constexpr size_t WS_Y = 112 * MiB;
constexpr size_t WS_G = 112 * MiB;
constexpr size_t WS_ACT = 288 * MiB;
constexpr size_t WS_Q = 288 * MiB, WS_K = 352 * MiB, WS_VT = 368 * MiB;
constexpr size_t WS_P = 288 * MiB, WS_Y2 = 352 * MiB;
constexpr size_t WS_END = 464 * MiB;

constexpr int LDS_BYTES = 147456, LDS_BARST = 131072 + 64;
constexpr int BAR_WORDS = 3456;

__device__ __forceinline__ unsigned f2bf(float f) { unsigned u = __builtin_bit_cast(unsigned, f); return (u + 0x7fffu + ((u >> 16) & 1u)) >> 16; }
__device__ __forceinline__ unsigned pk2(float lo, float hi) { return f2bf(lo) | (f2bf(hi) << 16); }
__device__ __forceinline__ float wave_sum(float v) {
#pragma unroll
    for (int o = 1; o < 64; o <<= 1) v += __shfl_xor(v, o);
    return v;
}

#define RLX_AGENT __ATOMIC_RELAXED, __HIP_MEMORY_SCOPE_AGENT
#define XB_TMO      128
#define XB_XCNT(j)  (256  + 64 * (j))
#define XB_XSUB(j)  (1280 + 64 * (j))
#define XB_XGEN(j)  (2304 + 64 * (j))
#define XB_TOP      3328
#define XB_TOPGEN   3392
#define XCD_BAR_WORDS 3456
#define XB_SPIN_CAP (1u << 18)

__device__ __forceinline__ unsigned xb_ld(unsigned* p)              { return __hip_atomic_load(p, __ATOMIC_RELAXED, __HIP_MEMORY_SCOPE_AGENT); }
__device__ __forceinline__ unsigned xb_add(unsigned* p, unsigned v) { return __hip_atomic_fetch_add(p, v, __ATOMIC_RELAXED, __HIP_MEMORY_SCOPE_AGENT); }
__device__ __forceinline__ unsigned xb_xcc_id() { return (unsigned)__builtin_amdgcn_s_getreg((3 << 11) | 20) & 0xFu; }
#define XB_SPIN(cond, bar) do { unsigned _sp = 0; while (cond) { __builtin_amdgcn_s_sleep(1); \
    if ((++_sp & 255u) == 0u) { if (xb_ld(&(bar)[XB_TMO])) break; if (_sp > XB_SPIN_CAP) { atomicAdd(&(bar)[XB_TMO], 1u); break; } } } } while (0)

struct XcdBarrier {
    unsigned* bar; unsigned x;
    volatile LAS unsigned* st;
};

__device__ __forceinline__ XcdBarrier xcd_barrier_post(unsigned* bar, volatile LAS unsigned* st) {
    XcdBarrier b; b.bar = bar; b.x = xb_xcc_id(); b.st = st;
    if (threadIdx.x == 0) (void)xb_add(&bar[XB_XCNT(b.x)], 1u);
    return b;
}
__device__ __forceinline__ void xcd_barrier_complete(unsigned* bar, unsigned x, unsigned& nloc, unsigned& nx) {
    const unsigned G = gridDim.x * gridDim.y * gridDim.z;
    unsigned sum, cnt, mine, sp = 0u;
    for (;;) {
        sum = 0u; cnt = 0u; mine = 0u;
#pragma unroll
        for (unsigned j = 0; j < 16; ++j) { const unsigned c = xb_ld(&bar[XB_XCNT(j)]); sum += c; cnt += (c > 0u) ? 1u : 0u; mine = (j == x) ? c : mine; }
        if (sum == G) break;
        __builtin_amdgcn_s_sleep(1);
        if ((++sp & 255u) == 0u) { if (xb_ld(&bar[XB_TMO])) break; if (sp > XB_SPIN_CAP) { atomicAdd(&bar[XB_TMO], 1u); break; } }
    }
    nloc = mine > 0u ? mine : 1u; nx = cnt > 0u ? cnt : 1u;
}

__device__ __forceinline__ void xcd_barrier(const XcdBarrier& b) {
    asm volatile("s_waitcnt vmcnt(0)" ::: "memory");
    __syncthreads();
    if (threadIdx.x == 0) {
        unsigned* bar = b.bar;
        __builtin_amdgcn_s_waitcnt(0);
        unsigned nloc = b.st[0], nx = b.st[1];
        if (nloc == 0u) { xcd_barrier_complete(bar, b.x, nloc, nx); b.st[0] = nloc; b.st[1] = nx; }
        const unsigned old = xb_add(&bar[XB_XSUB(b.x)], 1u);
        const unsigned gen = old / nloc;
        if (old + 1u == (gen + 1u) * nloc) {
            __builtin_amdgcn_fence(__ATOMIC_RELEASE, "agent");
            asm volatile("s_waitcnt vmcnt(0)" ::: "memory");
            const unsigned og = xb_add(&bar[XB_TOP], 1u);
            const unsigned tg = og / nx;
            if (og + 1u == (tg + 1u) * nx) xb_add(&bar[XB_TOPGEN], 1u);
            else XB_SPIN(xb_ld(&bar[XB_TOPGEN]) == tg, bar);
            __builtin_amdgcn_fence(__ATOMIC_ACQUIRE, "agent");
            xb_add(&bar[XB_XGEN(b.x)], 1u);
            asm volatile("s_waitcnt vmcnt(0)" ::: "memory");
        } else {
            XB_SPIN(xb_ld(&bar[XB_XGEN(b.x)]) == gen, bar);
            __builtin_amdgcn_fence(__ATOMIC_ACQUIRE, "agent");
            asm volatile("s_waitcnt vmcnt(0)" ::: "memory");
        }
    }
    __syncthreads();
}

namespace att {
constexpr int KSTR = 144, VSTR = 776, LDS_K = 0, LDS_V = 384 * KSTR;
__device__ __forceinline__ int crow(int r, int hi) { return (r & 3) + 8 * (r >> 2) + 4 * hi; }
#define MFMA32(a, b, c) __builtin_amdgcn_mfma_f32_32x32x16_bf16((a), (b), (c), 0, 0, 0)
__device__ __forceinline__ void attn_phase(LAS unsigned char* lds, bf16* Q, const bf16* Kg, const bf16* Vt, const float* sink) {
    int tid_ = threadIdx.x; asm volatile("" : "+v"(tid_));
    const int tid = tid_, lane = tid & 63, wid = __builtin_amdgcn_readfirstlane(tid >> 6), i32 = lane & 31, hi = lane >> 5;
    for (int u = blockIdx.x; u < BATCH * 16 * NKV; u += gridDim.x) {
        const int kvh = u & 3, blk = (u >> 2) & 15, b = u >> 6;
        const int tlo = blk == 0 ? 128 : 0, thi = blk == 15 ? 256 : 384;
        const long tok0 = (long)b * SEQ + blk * 128 - 128;
#pragma unroll
        for (int j = 0; j < 6; ++j) { const int id = tid + 512 * j, t = id >> 3, c = id & 7;
            if (t >= tlo && t < thi) { const u32x4 v = *(const u32x4*)(Kg + (tok0 + t) * 256 + kvh * 64 + c * 8); *(LAS u32x4*)(lds + LDS_K + t * KSTR + c * 16) = v; } }
#pragma unroll
        for (int j = 0; j < 6; ++j) { const int id = tid + 512 * j, d = id / 48, ch = id % 48, t = ch * 8;
            if (t >= tlo && t < thi) { const u32x4 v = *(const u32x4*)(Vt + (size_t)(kvh * 64 + d) * MTOK + tok0 + t);
                LAS u32x2* p = (LAS u32x2*)(lds + LDS_V + d * VSTR + ch * 16); p[0] = (u32x2){v.x, v.y}; p[1] = (u32x2){v.z, v.w}; } }
        __syncthreads();
        const int g = wid >> 1, r0 = (wid & 1) * 64, h = kvh * 4 + g;
        const long qrow0 = (long)b * SEQ + blk * 128 + r0;
        bf16x8 qf[2][4];
#pragma unroll
        for (int qt = 0; qt < 2; ++qt)
#pragma unroll
            for (int dc = 0; dc < 4; ++dc) qf[qt][dc] = *(const bf16x8*)(Q + (qrow0 + qt * 32 + i32) * 1024 + h * 64 + dc * 16 + hi * 8);
        f32x16 o[2][2];
#pragma unroll
        for (int a = 0; a < 2; ++a)
#pragma unroll
            for (int c = 0; c < 2; ++c)
#pragma unroll
                for (int r = 0; r < 16; ++r) o[a][c][r] = 0.f;
        const float sink2 = sink[h] * LOG2E;
        float mrun[2] = {sink2, sink2}, lrun[2] = {0.f, 0.f};
        const int ktlo = (tlo > r0 ? tlo : r0) >> 5, kthi = (thi < r0 + 320 ? thi : r0 + 320) >> 5;
        for (int kt = ktlo; kt < kthi; ++kt) {
            const int t0 = kt * 32;
            f32x16 s[2];
#pragma unroll
            for (int r = 0; r < 16; ++r) { s[0][r] = 0.f; s[1][r] = 0.f; }
#pragma unroll
            for (int dc = 0; dc < 4; ++dc) { const bf16x8 kf = *(const LAS bf16x8*)(lds + LDS_K + (t0 + i32) * KSTR + dc * 32 + hi * 16);
                s[0] = MFMA32(kf, qf[0][dc], s[0]); s[1] = MFMA32(kf, qf[1][dc], s[1]); }
            bf16x8 vf[2][2];
#pragma unroll
            for (int dt = 0; dt < 2; ++dt)
#pragma unroll
                for (int c = 0; c < 2; ++c) { const LAS unsigned char* vp = lds + LDS_V + (dt * 32 + i32) * VSTR + (t0 + 16 * c + 4 * hi) * 2;
                    const u32x2 lo = *(const LAS u32x2*)vp, hh = *(const LAS u32x2*)(vp + 16); vf[dt][c] = __builtin_bit_cast(bf16x8, (u32x4){lo.x, lo.y, hh.x, hh.y}); }
            const bool full = (t0 >= r0 + 63) && (t0 + 31 <= r0 + 256);
            if (!full) {
#pragma unroll
                for (int qt = 0; qt < 2; ++qt) { const int rq = r0 + qt * 32 + i32;
#pragma unroll
                    for (int r = 0; r < 16; ++r) { const int t = t0 + crow(r, hi); if (t < rq || t > rq + 256) s[qt][r] = -1e30f; } }
            }
#pragma unroll
            for (int qt = 0; qt < 2; ++qt) {
                float mx = s[qt][0];
#pragma unroll
                for (int r = 1; r < 16; ++r) mx = fmaxf(mx, s[qt][r]);
                mx = fmaxf(mx, __shfl_xor(mx, 32));
                const float mn = fmaxf(mrun[qt], mx), alpha = __builtin_amdgcn_exp2f(mrun[qt] - mn);
                mrun[qt] = mn; float ls = 0.f;
#pragma unroll
                for (int r = 0; r < 16; ++r) { const float p = __builtin_amdgcn_exp2f(s[qt][r] - mn); s[qt][r] = p; ls += p; }
                lrun[qt] = lrun[qt] * alpha + ls;
#pragma unroll
                for (int r = 0; r < 16; ++r) { o[qt][0][r] *= alpha; o[qt][1][r] *= alpha; }
                u32x4 p0, p1;
                p0.x = pg8::cvt_pk_bf16(s[qt][0], s[qt][1]); p0.y = pg8::cvt_pk_bf16(s[qt][2], s[qt][3]); p0.z = pg8::cvt_pk_bf16(s[qt][4], s[qt][5]); p0.w = pg8::cvt_pk_bf16(s[qt][6], s[qt][7]);
                p1.x = pg8::cvt_pk_bf16(s[qt][8], s[qt][9]); p1.y = pg8::cvt_pk_bf16(s[qt][10], s[qt][11]); p1.z = pg8::cvt_pk_bf16(s[qt][12], s[qt][13]); p1.w = pg8::cvt_pk_bf16(s[qt][14], s[qt][15]);
                const bf16x8 pf0 = __builtin_bit_cast(bf16x8, p0), pf1 = __builtin_bit_cast(bf16x8, p1);
#pragma unroll
                for (int dt = 0; dt < 2; ++dt) { o[qt][dt] = MFMA32(vf[dt][0], pf0, o[qt][dt]); o[qt][dt] = MFMA32(vf[dt][1], pf1, o[qt][dt]); }
            }
        }
#pragma unroll
        for (int qt = 0; qt < 2; ++qt) {
            const float lt = lrun[qt] + __shfl_xor(lrun[qt], 32) + __builtin_amdgcn_exp2f(sink2 - mrun[qt]);
            const float inv = 1.0f / lt;
            bf16* orow = Q + (qrow0 + qt * 32 + i32) * 1024 + h * 64 + 4 * hi;
#pragma unroll
            for (int dt = 0; dt < 2; ++dt)
#pragma unroll
                for (int r4 = 0; r4 < 4; ++r4) { u32x2 w; w.x = pg8::cvt_pk_bf16(o[qt][dt][4 * r4] * inv, o[qt][dt][4 * r4 + 1] * inv); w.y = pg8::cvt_pk_bf16(o[qt][dt][4 * r4 + 2] * inv, o[qt][dt][4 * r4 + 3] * inv);
                    *(u32x2*)(orow + dt * 32 + 8 * r4) = w; }
        }
        __syncthreads();
    }
}
}

__device__ __forceinline__ void row_pass(const float* rin, const bf16* y, const float* gpost, const float* gnext, float* rout, bf16* xn) {
    int tid_ = threadIdx.x; asm volatile("" : "+v"(tid_)); const int lane = tid_ & 63, wave = __builtin_amdgcn_readfirstlane(tid_ >> 6);
    const int gw = blockIdx.x * NWAVES + wave, NGW = gridDim.x * NWAVES;
    for (int row = gw; row < MTOK; row += NGW) {
        const size_t off = (size_t)row * DM + 4 * lane;
        f32x4 yv[4], hv[4]; float ss = 0.f;
#pragma unroll
        for (int j = 0; j < 4; ++j) { const u32x2 w = *(const u32x2*)(y + off + 256 * j);
            yv[j] = (f32x4){__uint_as_float(w.x << 16), __uint_as_float(w.x & 0xffff0000u), __uint_as_float(w.y << 16), __uint_as_float(w.y & 0xffff0000u)};
            ss += (yv[j][0] * yv[j][0] + yv[j][1] * yv[j][1]) + (yv[j][2] * yv[j][2] + yv[j][3] * yv[j][3]); }
        const float rstd = 1.0f / sqrtf(wave_sum(ss) * (1.0f / DM) + RMS_EPS);
        float s2 = 0.f;
#pragma unroll
        for (int j = 0; j < 4; ++j) { const f32x4 g = *(const f32x4*)(gpost + 4 * lane + 256 * j), r = *(const f32x4*)(rin + off + 256 * j);
            hv[j] = r + (yv[j] * rstd) * g; *(f32x4*)(rout + off + 256 * j) = hv[j];
            s2 += (hv[j][0] * hv[j][0] + hv[j][1] * hv[j][1]) + (hv[j][2] * hv[j][2] + hv[j][3] * hv[j][3]); }
        if (gnext) {
            const float rstd2 = 1.0f / sqrtf(wave_sum(s2) * (1.0f / DM) + RMS_EPS);
#pragma unroll
            for (int j = 0; j < 4; ++j) { const f32x4 g = *(const f32x4*)(gnext + 4 * lane + 256 * j); const f32x4 v = (hv[j] * rstd2) * g;
                u32x2 w; w.x = pk2(v[0], v[1]); w.y = pk2(v[2], v[3]); *(u32x2*)(xn + off + 256 * j) = w; }
        }
    }
}
__device__ __forceinline__ void norm_rows(const float* x, const float* g, bf16* xn) {
    int tid_ = threadIdx.x; asm volatile("" : "+v"(tid_)); const int lane = tid_ & 63, wave = __builtin_amdgcn_readfirstlane(tid_ >> 6);
    const int gw = blockIdx.x * NWAVES + wave, NGW = gridDim.x * NWAVES;
    for (int row = gw; row < MTOK; row += NGW) {
        const size_t off = (size_t)row * DM + 4 * lane;
        f32x4 v[4]; float ss = 0.f;
#pragma unroll
        for (int j = 0; j < 4; ++j) { v[j] = *(const f32x4*)(x + off + 256 * j); ss += (v[j][0] * v[j][0] + v[j][1] * v[j][1]) + (v[j][2] * v[j][2] + v[j][3] * v[j][3]); }
        const float rstd = 1.0f / sqrtf(wave_sum(ss) * (1.0f / DM) + RMS_EPS);
#pragma unroll
        for (int j = 0; j < 4; ++j) { const f32x4 gg = *(const f32x4*)(g + 4 * lane + 256 * j); const f32x4 o = (v[j] * rstd) * gg;
            u32x2 w; w.x = pk2(o[0], o[1]); w.y = pk2(o[2], o[3]); *(u32x2*)(xn + off + 256 * j) = w; }
    }
}

__device__ __forceinline__ int map_col(int mode, int n) {
    if (mode == 1) {
        if (n >= 1280) return n;
        const int p = n & 63, j = p >> 3, e = p & 7; return (n & ~63) + (e < 4 ? 4 * j + e : 32 + 4 * j + (e - 4));
    }
    if (mode == 2) {
        if (n >= 2048) return n - 2048;
        const int j = n >> 8, hsel = (n >> 7) & 1, i = n & 127; return 1024 + hsel * 1024 + 128 * j + i;
    }
    return n;
}
__device__ __forceinline__ void transpose_item(const float* W, int K, int N, bf16* WT, int mode, LAS float* scr, int item, int lane) {
    const int nblk = N / 32, kb = item / nblk, nb = item % nblk, k0 = 64 * kb, n0 = 32 * nb;
    const int src = map_col(mode, n0 + (lane & 31));
#pragma unroll 8
    for (int i = 0; i < 32; ++i) { const int kk = 2 * i + (lane >> 5); scr[kk * 33 + (lane & 31)] = W[(size_t)(k0 + kk) * N + src]; }
    asm volatile("s_waitcnt lgkmcnt(0)" ::: "memory");
    const int c = lane & 7;
#pragma unroll
    for (int j = 0; j < 4; ++j) { const int n = (lane >> 3) + 8 * j; const LAS float* s = scr + (8 * c) * 33 + n;
        u32x4 o; o.x = pk2(s[0 * 33], s[1 * 33]); o.y = pk2(s[2 * 33], s[3 * 33]); o.z = pk2(s[4 * 33], s[5 * 33]); o.w = pk2(s[6 * 33], s[7 * 33]);
        *(u32x4*)(WT + (size_t)(n0 + n) * K + k0 + 8 * c) = o; }
    asm volatile("s_waitcnt lgkmcnt(0)" ::: "memory");
}
__device__ const float INV_FREQ[32] = {1.000000000e+00f, 7.498942614e-01f, 5.623413324e-01f, 4.216965139e-01f, 3.162277639e-01f, 2.371373773e-01f, 1.778279394e-01f, 1.333521307e-01f, 1.000000015e-01f, 7.498941571e-02f, 5.623413250e-02f, 4.216965288e-02f, 3.162277490e-02f, 2.371373773e-02f, 1.778279431e-02f, 1.333521493e-02f, 9.999999776e-03f, 7.498941850e-03f, 5.623413250e-03f, 4.216964822e-03f, 3.162277630e-03f, 2.371373586e-03f, 1.778279431e-03f, 1.333521446e-03f, 1.000000047e-03f, 7.498942432e-04f, 5.623413017e-04f, 4.216965172e-04f, 3.162277571e-04f, 2.371373703e-04f, 1.778279402e-04f, 1.333521504e-04f};
__device__ __forceinline__ void sincos_f64(float angf, float& c, float& s) {
    const double a = (double)angf, k = __builtin_rint(a * 0.63661977236758134308);
    double r = __builtin_fma(-k, 1.57079632679489655800e+00, a); r = __builtin_fma(-k, 6.12323399573676603587e-17, r);
    const double r2 = r * r;
    double sp = -1.0 / 1307674368000.0; sp = sp * r2 + 1.0 / 6227020800.0; sp = sp * r2 - 1.0 / 39916800.0; sp = sp * r2 + 1.0 / 362880.0; sp = sp * r2 - 1.0 / 5040.0; sp = sp * r2 + 1.0 / 120.0; sp = sp * r2 - 1.0 / 6.0; sp = sp * r2 + 1.0;
    double cp = 1.0 / 20922789888000.0; cp = cp * r2 - 1.0 / 87178291200.0; cp = cp * r2 + 1.0 / 479001600.0; cp = cp * r2 - 1.0 / 3628800.0; cp = cp * r2 + 1.0 / 40320.0; cp = cp * r2 - 1.0 / 720.0; cp = cp * r2 + 1.0 / 24.0; cp = cp * r2 - 0.5; cp = cp * r2 + 1.0;
    const double sr = sp * r, cr = cp; const int q = (int)((long long)k & 3);
    const double cc = (q == 0) ? cr : (q == 1) ? -sr : (q == 2) ? -cr : sr;
    const double sv = (q == 0) ? sr : (q == 1) ? cr : (q == 2) ? -sr : -cr;
    c = (float)cc; s = (float)sv;
}

#ifndef PHASES
#define PHASES 0xffff
#endif
#define PH(k) ((PHASES >> (k)) & 1)
struct Args { const float* in[12]; float* out; unsigned char* ws; };

typedef const Args __attribute__((address_space(4)))* ArgsP;
#define PTRS ArgsP ap_ = (ArgsP)__builtin_amdgcn_kernarg_segment_ptr(); asm volatile("" : "+s"(ap_)); \
    unsigned char* ws = ap_->ws; (void)ws; \
    const float* x = ap_->in[0]; const int* positions = (const int*)ap_->in[1]; const float* w_qkv = ap_->in[2]; const float* sink = ap_->in[3]; const float* w_o = ap_->in[4]; \
    const float* w_in = ap_->in[5]; const float* conv_w = ap_->in[6]; const float* w_out = ap_->in[7]; const float* gains = ap_->in[8]; const float* w_gu = ap_->in[9]; \
    const float* ffn_cw = ap_->in[10]; const float* w_dn = ap_->in[11]; float* out = ap_->out; \
    bf16* Wqkv_t = (bf16*)(ws + WS_WQKV); bf16* Wo_t = (bf16*)(ws + WS_WO); bf16* Win_t = (bf16*)(ws + WS_WIN); bf16* Wout_t = (bf16*)(ws + WS_WOUT); \
    bf16* Wgu_t = (bf16*)(ws + WS_WGU); bf16* Wd_t = (bf16*)(ws + WS_WD); float* rcos = (float*)(ws + WS_ROPE); float* rsin = rcos + SEQ * 32; \
    bf16* XN = (bf16*)(ws + WS_XN); bf16* Y = (bf16*)(ws + WS_Y); bf16* GB = (bf16*)(ws + WS_G); bf16* ACT = (bf16*)(ws + WS_ACT); \
    bf16* QB = (bf16*)(ws + WS_Q); bf16* KB = (bf16*)(ws + WS_K); bf16* VT = (bf16*)(ws + WS_VT); bf16* PB = (bf16*)(ws + WS_P); bf16* Y2 = (bf16*)(ws + WS_Y2); \
    (void)x; (void)positions; (void)w_qkv; (void)sink; (void)w_o; (void)w_in; (void)conv_w; (void)w_out; (void)gains; (void)w_gu; (void)ffn_cw; (void)w_dn; (void)out; \
    (void)Wqkv_t; (void)Wo_t; (void)Win_t; (void)Wout_t; (void)Wgu_t; (void)Wd_t; (void)rcos; (void)rsin; (void)XN; (void)Y; (void)GB; (void)ACT; (void)QB; (void)KB; (void)VT; (void)PB; (void)Y2; \
    const int G = gridDim.x; (void)G

__global__ void __launch_bounds__(NWAVES * 64, 2) fwd_megakernel(Args args) {
    extern __shared__ __attribute__((aligned(16))) unsigned char lds_raw[];
    LAS unsigned char* lds = (LAS unsigned char*)lds_raw;
    cg::grid_group grid = cg::this_grid();
#define SYNC() do { ArgsP bp_ = (ArgsP)__builtin_amdgcn_kernarg_segment_ptr(); XcdBarrier b_; b_.bar = (unsigned*)(bp_->ws + WS_CTL); b_.x = xb_xcc_id(); b_.st = (volatile LAS unsigned*)(lds + LDS_BARST); xcd_barrier(b_); } while (0)
    if (threadIdx.x == 0) { ((volatile LAS unsigned*)(lds + LDS_BARST))[0] = 0u; ((volatile LAS unsigned*)(lds + LDS_BARST))[1] = 0u; }
    if (blockIdx.x == 0) { unsigned* ctl = (unsigned*)(args.ws + WS_CTL); for (int i = threadIdx.x; i < BAR_WORDS; i += NWAVES * 64) ctl[i] = 0u; }
    __syncthreads();

    if (PH(0)) {
        PTRS;
        int tid_ = threadIdx.x; asm volatile("" : "+v"(tid_)); const int tid = tid_, lane = tid & 63, wave = __builtin_amdgcn_readfirstlane(tid >> 6);
        LAS float* scr = (LAS float*)(lds + wave * 16384);
        const int gw = blockIdx.x * NWAVES + wave, NGW = G * NWAVES;
        constexpr int I_QKV = 16 * (NQKV / 32), I_O = 16 * 32, I_IN = 16 * 96, I_OUT = 16 * 32, I_GU = 16 * (2 * FF / 32), I_D = (FF / 64) * 32;
        constexpr int NITEMS = I_QKV + I_O + I_IN + I_OUT + 2 * I_GU + 2 * I_D;
        for (int it = gw; it < NITEMS; it += NGW) {
            int r = it;
            if (r < I_QKV) { transpose_item(w_qkv, DM, NQKV, Wqkv_t, 1, scr, r, lane); continue; } r -= I_QKV;
            if (r < I_O) { transpose_item(w_o, DM, DM, Wo_t, 0, scr, r, lane); continue; } r -= I_O;
            if (r < I_IN) { transpose_item(w_in, DM, 3 * DM, Win_t, 2, scr, r, lane); continue; } r -= I_IN;
            if (r < I_OUT) { transpose_item(w_out, DM, DM, Wout_t, 0, scr, r, lane); continue; } r -= I_OUT;
            if (r < I_GU) { transpose_item(w_gu, DM, 2 * FF, Wgu_t, 0, scr, r, lane); continue; } r -= I_GU;
            if (r < I_GU) { transpose_item(w_gu + (size_t)DM * 2 * FF, DM, 2 * FF, Wgu_t + (size_t)2 * FF * DM, 0, scr, r, lane); continue; } r -= I_GU;
            if (r < I_D) { transpose_item(w_dn, FF, DM, Wd_t, 0, scr, r, lane); continue; } r -= I_D;
            transpose_item(w_dn + (size_t)FF * DM, FF, DM, Wd_t + (size_t)DM * FF, 0, scr, r, lane);
        }
        for (int e = blockIdx.x * (NWAVES * 64) + tid; e < SEQ * 32; e += G * NWAVES * 64) {
            const int s = e >> 5, i = e & 31; const float ang = (float)positions[s] * INV_FREQ[i];
            float c, sn; sincos_f64(ang, c, sn); rcos[e] = c; rsin[e] = sn;
        }
        norm_rows(x, gains, XN);
    }
    grid.sync();
    if (threadIdx.x == 0) (void)xb_add(&((unsigned*)(args.ws + WS_CTL))[XB_XCNT(xb_xcc_id())], 1u);
    if (PH(1)) {
        PTRS;
        pg8::Gemm g{XN, Wqkv_t, MTOK, 1280, DM, Wqkv_t + (size_t)1280 * DM, XN}; pg8::StaticOrder S; S.init(MTOK, 1280, G, (int)blockIdx.x, MTOK / 256);
        pg8::EpiQKV E{QB, (long)((WS_K - WS_Q) / 2), (long)((WS_VT - WS_Q) / 2), rcos, rsin, 0.125f * LOG2E, MTOK};
        pg8::gemm_phase<pg8::EpiQKV, pg8::StaticOrder, true, true>(lds, g, S, E);
    }
    SYNC();
    if (PH(2)) { PTRS; att::attn_phase(lds, QB, KB, VT, sink); }
    SYNC();
    if (PH(3)) {
        PTRS;
        pg8::Gemm g{QB, Wo_t, MTOK, DM, DM, nullptr, nullptr}; pg8::StaticOrder S; S.init(MTOK, DM, G, (int)blockIdx.x);
        pg8::EpiStore E{Y, DM};
        pg8::gemm_phase<pg8::EpiStore, pg8::StaticOrder, true, true>(lds, g, S, E);
    }
    SYNC();
    if (PH(4)) { PTRS; row_pass(x, Y, gains + 1 * DM, gains + 2 * DM, out, XN); }
    SYNC();
#pragma unroll 1
    for (int layer = 0; layer < 2; ++layer) {
        if (PH(5) && layer == 1) {
            if (PH(7)) {
                PTRS;
                pg8::Gemm g{XN, Win_t, MTOK, 2048, DM, nullptr, nullptr}; pg8::StaticOrder S; S.init(MTOK, 2048, G, (int)blockIdx.x);
                pg8::EpiCX E{PB};
                pg8::gemm_phase<pg8::EpiCX, pg8::StaticOrder, true, true>(lds, g, S, E);
            }
            SYNC();
            if (PH(8)) {
                PTRS;
                pg8::Gemm g{XN, Win_t + (size_t)2048 * DM, MTOK, DM, DM, nullptr, nullptr}; pg8::StaticOrder S; S.init(MTOK, DM, G, (int)blockIdx.x);
                pg8::EpiConv<0> E{PB, conv_w, Y2, DM};
                pg8::gemm_phase<pg8::EpiConv<0>, pg8::StaticOrder, true, true>(lds, g, S, E);
            }
            SYNC();
            if (PH(9)) {
                PTRS;
                pg8::Gemm g{Y2, Wout_t, MTOK, DM, DM, nullptr, nullptr}; pg8::StaticOrder S; S.init(MTOK, DM, G, (int)blockIdx.x);
                pg8::EpiStore E{Y, DM};
                pg8::gemm_phase<pg8::EpiStore, pg8::StaticOrder, true, true>(lds, g, S, E);
            }
            SYNC();
            { PTRS; row_pass(out, Y, gains + 5 * DM, gains + 6 * DM, out, XN); }
            SYNC();
        }
        if (!PH(6)) continue;
        if (PH(10)) {
            PTRS; const bf16* Wg = Wgu_t + (size_t)layer * 2 * FF * DM;
            pg8::Gemm g{XN, Wg, MTOK, FF, DM, nullptr, nullptr}; pg8::StaticOrder S; S.init(MTOK, FF, G, (int)blockIdx.x);
            pg8::EpiStore E{GB, FF};
            pg8::gemm_phase<pg8::EpiStore, pg8::StaticOrder, true, true>(lds, g, S, E);
        }
        SYNC();
        if (PH(11)) {
            PTRS; const bf16* Wg = Wgu_t + (size_t)layer * 2 * FF * DM;
            pg8::Gemm g{XN, Wg + (size_t)FF * DM, MTOK, FF, DM, nullptr, nullptr}; pg8::StaticOrder S; S.init(MTOK, FF, G, (int)blockIdx.x);
            pg8::EpiConv<1> E{GB, ffn_cw + (size_t)layer * 3 * FF, ACT, FF};
            pg8::gemm_phase<pg8::EpiConv<1>, pg8::StaticOrder, true, true>(lds, g, S, E);
        }
        SYNC();
        if (PH(12)) {
            PTRS; const bf16* Wd = Wd_t + (size_t)layer * DM * FF;
            pg8::Gemm g{ACT, Wd, MTOK, DM, FF, nullptr, nullptr}; pg8::StaticOrder S; S.init(MTOK, DM, G, (int)blockIdx.x);
            pg8::EpiStore E{Y, DM};
            pg8::gemm_phase<pg8::EpiStore, pg8::StaticOrder, true, true>(lds, g, S, E);
        }
        SYNC();
        { PTRS; row_pass(out, Y, gains + (layer * 4 + 3) * DM, layer == 0 ? gains + 4 * DM : nullptr, out, XN); }
        if (layer == 0) SYNC();
    }
}

extern "C" void kernel_launch(void* const* d_in, const int* in_sizes, int n_in, void* d_out, int out_size, void* d_ws, size_t ws_size, hipStream_t stream) {
    static int grid = 0;
    if (grid == 0) {
        if (n_in != 12 || in_sizes[0] != MTOK * DM || out_size != MTOK * DM || ws_size < WS_END) { fprintf(stderr, "kernel_launch: unexpected shapes / workspace (n_in %d, in0 %d, out %d, ws %zu)\n", n_in, n_in > 0 ? in_sizes[0] : -1, out_size, ws_size); grid = -1; return; }
        int dev = 0, cus = 0, per_cu = 0;
        hipGetDevice(&dev); hipDeviceGetAttribute(&cus, hipDeviceAttributeMultiprocessorCount, dev);
        if (hipFuncSetAttribute((const void*)fwd_megakernel, hipFuncAttributeMaxDynamicSharedMemorySize, LDS_BYTES) != hipSuccess) { fprintf(stderr, "kernel_launch: hipFuncSetAttribute failed\n"); grid = -1; return; }
        if (hipOccupancyMaxActiveBlocksPerMultiprocessor(&per_cu, (const void*)fwd_megakernel, NWAVES * 64, LDS_BYTES) != hipSuccess || per_cu < 1) { fprintf(stderr, "kernel_launch: occupancy query says %d\n", per_cu); per_cu = 1; }
        (void)hipGetLastError();
        grid = cus * per_cu;
    }
    if (grid < 0) return;
    Args a{};
    for (int i = 0; i < 12; ++i) a.in[i] = (const float*)d_in[i];
    a.out = (float*)d_out; a.ws = (unsigned char*)d_ws;
    void* kargs[] = {&a};
    hipError_t e = hipLaunchCooperativeKernel((const void*)fwd_megakernel, dim3(grid), dim3(NWAVES * 64), kargs, LDS_BYTES, stream);
    if (e != hipSuccess) fprintf(stderr, "kernel_launch: cooperative launch failed: %s (grid %d)\n", hipGetErrorString(e), grid);
}
```

```cpp
#include <hip/hip_runtime.h>
#include <hip/hip_cooperative_groups.h>
#include <cstdio>
#include <cstdint>
namespace cg = cooperative_groups;
namespace pg8 {
#define PG8_LAS __attribute__((address_space(3)))
typedef unsigned short bf16_t;
typedef short bf16x8 __attribute__((ext_vector_type(8)));
typedef float f32x4 __attribute__((ext_vector_type(4)));
typedef unsigned u32x4 __attribute__((ext_vector_type(4)));
constexpr int BM = 256, BK = 64, HALF = 128, HTB = HALF * BK * 2  , STAGE_BYTES = 8 * HTB, NXCD = 8, WGM = 8;

__host__ __device__ __forceinline__ int lds_byte(int r, int c) { const int st = (r >> 4) * 2 + (c >> 5), rr = r & 15, cc = c & 31, ob = rr * 64 + cc * 2; return st * 1024 + (ob ^ (((ob >> 9) & 1) << 5)); }
__host__ __device__ __forceinline__ void stage_rc(int b, int& R, int& C) { const int st = b / 1024, sb = b % 1024, swz = sb ^ (((sb >> 9) & 1) << 5); R = (st >> 1) * 16 + swz / 64; C = (st & 1) * 32 + (swz % 64) / 2; }
__host__ __device__ __forceinline__ int perm32(int rho) { const int n = rho >> 4, i = rho & 15; return 8 * (i >> 2) + 4 * n + (i & 3); }

typedef unsigned u32x2 __attribute__((ext_vector_type(2)));
struct Unit { int pm, pn, w; };
struct Gemm { const bf16_t* A; const bf16_t* Bt; int M, N, K; const bf16_t* A2; const bf16_t* Bt2; };

struct StaticOrder {
    int nM, nN, nwg, G, c, n2;
    __host__ __device__ void init(int M, int N, int G_, int c_, int n2_ = 0) { nM = M / BM; nN = N / BM; nwg = nM * nN; G = G_; c = c_; n2 = n2_; }
    __host__ __device__ bool next(int i, Unit& u) const {
        const long L = (long)i * G + c; if (L >= nwg + n2) return false;
        if (L >= nwg) { u.w = 1; u.pm = 0; u.pn = (int)(L - nwg); return true; }
        u.w = 0;
        int wgid = (int)L; { const int q = nwg / NXCD, r = nwg % NXCD, xcd = wgid % NXCD, off = wgid / NXCD; wgid = (xcd < r ? xcd * (q + 1) : r * (q + 1) + (xcd - r) * q) + off; }
        const int nig = WGM * nN, gid = wgid / nig, fm = gid * WGM, gsz = (nM - fm) < WGM ? (nM - fm) : WGM;
        u.pm = fm + ((wgid % nig) % gsz); u.pn = (wgid % nig) / gsz; return true;
    }
    __device__ __forceinline__ void a_ready(const Unit&) const {}
    __device__ __forceinline__ void done(const Unit&) const {}
};

__device__ __forceinline__ unsigned cvt_pk_bf16(float lo, float hi) { unsigned r; asm volatile("v_cvt_pk_bf16_f32 %0, %1, %2" : "=v"(r) : "v"(lo), "v"(hi)); return r; }
__device__ __forceinline__ u32x4 pack8(const f32x4 a, const f32x4 b) { u32x4 w; w.x = cvt_pk_bf16(a[0], a[1]); w.y = cvt_pk_bf16(a[2], a[3]); w.z = cvt_pk_bf16(b[0], b[1]); w.w = cvt_pk_bf16(b[2], b[3]); return w; }
__device__ __forceinline__ f32x4 bf_lo4(const u32x4 w) { return (f32x4){__uint_as_float(w.x << 16), __uint_as_float(w.x & 0xffff0000u), __uint_as_float(w.y << 16), __uint_as_float(w.y & 0xffff0000u)}; }
__device__ __forceinline__ f32x4 bf_hi4(const u32x4 w) { return (f32x4){__uint_as_float(w.z << 16), __uint_as_float(w.z & 0xffff0000u), __uint_as_float(w.w << 16), __uint_as_float(w.w & 0xffff0000u)}; }

struct EpiStore {
    static constexpr bool PERM = true, AFTER_DRAIN = false;
    bf16_t* O; int ldc;
    __device__ __forceinline__ void operator()(const f32x4 (&acc)[2][2][4][2], const Unit& u, int wr, int wc, int fr, int fq) const {
        const int row0 = u.pm * BM + wr * 64 + fr, col0 = u.pn * BM + wc * 32 + 8 * fq;
#pragma unroll
        for (int ai = 0; ai < 2; ++ai)
#pragma unroll
            for (int m = 0; m < 4; ++m) { bf16_t* rowp = O + (size_t)(row0 + ai * HALF + m * 16) * ldc + col0;
#pragma unroll
                for (int bj = 0; bj < 2; ++bj) *(u32x4*)(rowp + bj * HALF) = pack8(acc[ai][bj][m][0], acc[ai][bj][m][1]); }
    }
};

struct EpiQKV {
    static constexpr bool PERM = true, AFTER_DRAIN = false;
    bf16_t* Q; long offK, offV; const float* rcos; const float* rsin; float qscale; int mtok;
    __device__ __forceinline__ void operator()(const f32x4 (&acc)[2][2][4][2], const Unit& u, int wr, int wc, int fr, int fq) const {
        const bool isv = u.w != 0, isq = u.pn < 4;
        bf16_t* base = Q + (isv ? offV : (isq ? 0L : offK)); const int ldc = isv ? mtok : (isq ? 1024 : 256), colt = (isv || isq) ? u.pn * BM : 0; const float sc = (!isv && isq) ? qscale : 1.0f;
        const int i0 = 4 * ((wc & 1) * 4 + fq);
#pragma unroll
        for (int ai = 0; ai < 2; ++ai)
#pragma unroll
            for (int m = 0; m < 4; ++m) {
                const int row = u.pm * BM + ai * HALF + wr * 64 + m * 16 + fr, s = row & 2047;
                f32x4 c = (f32x4){1.f, 1.f, 1.f, 1.f}, sn = (f32x4){0.f, 0.f, 0.f, 0.f};
                if (!isv) { c = *(const f32x4*)(rcos + s * 32 + i0) * sc; sn = *(const f32x4*)(rsin + s * 32 + i0) * sc; }
                bf16_t* rowp = base + (size_t)row * ldc + colt + wc * 32 + 8 * fq;
#pragma unroll
                for (int bj = 0; bj < 2; ++bj) { const f32x4 x1 = acc[ai][bj][m][0], x2 = acc[ai][bj][m][1];
                    *(u32x4*)(rowp + bj * HALF) = pack8(x1 * c - x2 * sn, x2 * c + x1 * sn); }
                if (m & 1) asm volatile("" ::: "memory");
            }
    }
};

struct EpiCX {
    static constexpr bool PERM = true, AFTER_DRAIN = false;
    bf16_t* P;
    __device__ __forceinline__ void operator()(const f32x4 (&acc)[2][2][4][2], const Unit& u, int wr, int wc, int fr, int fq) const {
        const int row0 = u.pm * BM + wr * 64 + fr, col0 = u.pn * HALF + wc * 32 + 8 * fq;
#pragma unroll
        for (int ai = 0; ai < 2; ++ai)
#pragma unroll
            for (int m = 0; m < 4; ++m)
                *(u32x4*)(P + (size_t)(row0 + ai * HALF + m * 16) * 1024 + col0) = pack8(acc[ai][0][m][0] * acc[ai][1][m][0], acc[ai][0][m][1] * acc[ai][1][m][1]);
    }
};

template <int MODE> struct EpiConv {
    static constexpr bool PERM = true, AFTER_DRAIN = false;
    const bf16_t* G; const float* cw; bf16_t* O; int ldc;
    __device__ __forceinline__ void operator()(const f32x4 (&acc)[2][2][4][2], const Unit& u, int wr, int wc, int fr, int fq) const {
        const int row0 = u.pm * BM + wr * 64 + fr;
#pragma unroll
        for (int bj = 0; bj < 2; ++bj) {
            const int col = u.pn * BM + bj * HALF + wc * 32 + 8 * fq;
            const f32x4 w0a = *(const f32x4*)(cw + col), w0b = *(const f32x4*)(cw + col + 4);
            const f32x4 w1a = *(const f32x4*)(cw + ldc + col), w1b = *(const f32x4*)(cw + ldc + col + 4);
            const f32x4 w2a = *(const f32x4*)(cw + 2 * ldc + col), w2b = *(const f32x4*)(cw + 2 * ldc + col + 4);
#pragma unroll
            for (int ai = 0; ai < 2; ++ai)
#pragma unroll
                for (int m = 0; m < 4; ++m) {
                    const int row = row0 + ai * HALF + m * 16, s = row & 2047;
                    const bf16_t* gp = G + (size_t)row * ldc + col;
                    const u32x4 zc = *(const u32x4*)gp;
                    u32x4 zp = (u32x4){0u, 0u, 0u, 0u}, zn = (u32x4){0u, 0u, 0u, 0u};
                    if (s > 0) zp = *(const u32x4*)(gp - ldc);
                    if (s < 2047) zn = *(const u32x4*)(gp + ldc);
                    f32x4 za = w0a * bf_lo4(zp) + w1a * bf_lo4(zc) + w2a * bf_lo4(zn);
                    f32x4 zb = w0b * bf_hi4(zp) + w1b * bf_hi4(zc) + w2b * bf_hi4(zn);
                    f32x4 oa, ob;
                    if (MODE == 0) { oa = acc[ai][bj][m][0] * za; ob = acc[ai][bj][m][1] * zb; }
                    else {
#pragma unroll
                        for (int e = 0; e < 4; ++e) {
                            oa[e] = za[e] * __builtin_amdgcn_rcpf(1.0f + __builtin_amdgcn_exp2f(za[e] * -1.4426950408889634f)) * acc[ai][bj][m][0][e];
                            ob[e] = zb[e] * __builtin_amdgcn_rcpf(1.0f + __builtin_amdgcn_exp2f(zb[e] * -1.4426950408889634f)) * acc[ai][bj][m][1][e]; }
                    }
                    *(u32x4*)(O + (size_t)row * ldc + col) = pack8(oa, ob);
                    if (m & 1) asm volatile("" ::: "memory");
                }
        }
    }
};

__device__ __forceinline__ float dpp_shr1(float oldv, float src) { return __int_as_float(__builtin_amdgcn_update_dpp(__float_as_int(oldv), __float_as_int(src), 0x111, 0xf, 0xf, false)); }
__device__ __forceinline__ float dpp_shl1(float oldv, float src) { return __int_as_float(__builtin_amdgcn_update_dpp(__float_as_int(oldv), __float_as_int(src), 0x101, 0xf, 0xf, false)); }
__device__ __forceinline__ float dpp_ror1(float src) { return __int_as_float(__builtin_amdgcn_update_dpp(0, __float_as_int(src), 0x121, 0xf, 0xf, false)); }
__device__ __forceinline__ float dpp_ror15(float src) { return __int_as_float(__builtin_amdgcn_update_dpp(0, __float_as_int(src), 0x12F, 0xf, 0xf, false)); }
struct EpiGU {
    static constexpr bool PERM = true, AFTER_DRAIN = false;
    const bf16_t* GH; const float* cw; bf16_t* ACT; PG8_LAS unsigned char* xlds; int ff;
    __device__ __forceinline__ void operator()(const f32x4 (&acc)[2][2][4][2], const Unit& u, int wr, int wc, int fr, int fq) const {
        const int colg = 32 * wc + 8 * fq, ch0 = u.pn * HALF + colg, pmod = u.pm & 7;
        f32x4 w0[2], w1[2], w2[2];
#pragma unroll
        for (int n = 0; n < 2; ++n) { w0[n] = *(const f32x4*)(cw + ch0 + 4 * n); w1[n] = *(const f32x4*)(cw + ff + ch0 + 4 * n); w2[n] = *(const f32x4*)(cw + 2 * ff + ch0 + 4 * n); }
        f32x4 top[2], bot[2];
#pragma unroll
        for (int n = 0; n < 2; ++n) { top[n] = (f32x4){0.f, 0.f, 0.f, 0.f}; bot[n] = (f32x4){0.f, 0.f, 0.f, 0.f}; }
        if (wr == 0 && fr == 0 && pmod != 0) { const u32x4 v = *(const u32x4*)(GH + (size_t)(2 * u.pm) * (2 * ff) + u.pn * BM + colg); top[0] = bf_lo4(v); top[1] = bf_hi4(v); }
        if (wr == 1 && fr == 15 && pmod != 7) { const u32x4 v = *(const u32x4*)(GH + (size_t)(2 * (u.pm + 1) + 1) * (2 * ff) + u.pn * BM + colg); bot[0] = bf_lo4(v); bot[1] = bf_hi4(v); }
        PG8_LAS float* XF = (PG8_LAS float*)xlds; PG8_LAS float* XL = XF + 4 * HALF;
        if (fr == 0) {
#pragma unroll
            for (int ai = 0; ai < 2; ++ai)
#pragma unroll
                for (int n = 0; n < 2; ++n) *(PG8_LAS f32x4*)(XF + (2 * ai + wr) * HALF + colg + 4 * n) = acc[ai][0][0][n];
        }
        if (fr == 15) {
#pragma unroll
            for (int ai = 0; ai < 2; ++ai)
#pragma unroll
                for (int n = 0; n < 2; ++n) *(PG8_LAS f32x4*)(XL + (2 * ai + wr) * HALF + colg + 4 * n) = acc[ai][0][3][n];
        }
        asm volatile("s_waitcnt lgkmcnt(0)" ::: "memory"); __builtin_amdgcn_s_barrier(); asm volatile("" ::: "memory");
#pragma unroll
        for (int ai = 0; ai < 2; ++ai) {
            const int k = 2 * ai + wr;
            f32x4 pr[2], nx[2];
#pragma unroll
            for (int n = 0; n < 2; ++n) {
                pr[n] = (k == 0) ? top[n] : *(const PG8_LAS f32x4*)(XL + (k - 1) * HALF + colg + 4 * n);
                nx[n] = (k == 3) ? bot[n] : *(const PG8_LAS f32x4*)(XF + ((k + 1) & 3) * HALF + colg + 4 * n);
            }
#pragma unroll
            for (int m = 0; m < 4; ++m) {
                f32x4 o[2];
#pragma unroll
                for (int n = 0; n < 2; ++n)
#pragma unroll
                    for (int e = 0; e < 4; ++e) {
                        const float g = acc[ai][0][m][n][e];
                        const float oldp = (m == 0) ? pr[n][e] : dpp_ror1(acc[ai][0][m > 0 ? m - 1 : 0][n][e]);
                        const float oldn = (m == 3) ? nx[n][e] : dpp_ror15(acc[ai][0][m < 3 ? m + 1 : 3][n][e]);
                        const float P = dpp_shr1(oldp, g), N = dpp_shl1(oldn, g);
                        const float z = w0[n][e] * P + w1[n][e] * g + w2[n][e] * N;
                        o[n][e] = z * __builtin_amdgcn_rcpf(1.0f + __builtin_amdgcn_exp2f(z * -1.4426950408889634f)) * acc[ai][1][m][n][e];
                    }
                *(u32x4*)(ACT + (size_t)(u.pm * BM + ai * HALF + wr * 64 + m * 16 + fr) * ff + ch0) = pack8(o[0], o[1]);
            }
        }
    }
};

template <class Epi, class Sched, bool ALIGN_EPI = false, bool SP2 = false>
__device__ __forceinline__ void gemm_phase(PG8_LAS unsigned char* lds, const Gemm g, const Sched& S, const Epi& E) {
    int tid_ = threadIdx.x; asm volatile("" : "+v"(tid_));
    const int tid = tid_, wid = __builtin_amdgcn_readfirstlane(tid >> 6), lane = tid & 63, wr = wid >> 2, wc = wid & 3, fr = lane & 15, fq = lane >> 4;
    const int K = g.K, nt = K / BK;
    unsigned voffA[2], voffB[2];
#pragma unroll
    for (int i = 0; i < 2; ++i) { int R, C; stage_rc(tid * 16 + i * 8192, R, C); const int Rb = Epi::PERM ? ((R & ~31) + perm32(R & 31)) : R;
        voffA[i] = (unsigned)(R * K + C) * 2u; voffB[i] = (unsigned)(Rb * K + C) * 2u; }
    const size_t kstep = (size_t)(BK * 2);
    const size_t hstep = (size_t)HALF * K * 2;
    const size_t tstep = 2 * hstep;
    const unsigned ldsw = (unsigned)wid * 1024u;
    const int aoff = lds_byte(wr * 64 + fr, fq * 8), boff = lds_byte(wc * 32 + fr, fq * 8);
#define PG8_SA(b, h) (((b) * 2 + (h)) * HTB)
#define PG8_SB(b, h) ((4 + (b) * 2 + (h)) * HTB)
#define PG8_STAGE(bufoff, gbase, voff) do { _Pragma("unroll") for (int _i = 0; _i < 2; ++_i) \
        __builtin_amdgcn_global_load_lds((const unsigned*)((const char*)(gbase) + (voff)[_i]), (PG8_LAS unsigned*)(lds + (bufoff) + ldsw + _i * 8192), 16, 0, 0); } while (0)
#define PG8_LDA(dst, b, h) do { _Pragma("unroll") for (int m = 0; m < 4; ++m) _Pragma("unroll") for (int k = 0; k < 2; ++k) dst[m][k] = *(const PG8_LAS bf16x8*)(lds + PG8_SA(b, h) + aoff + m * 2048 + k * 1024); } while (0)
#define PG8_LDB(dst, b, h) do { _Pragma("unroll") for (int n = 0; n < 2; ++n) _Pragma("unroll") for (int k = 0; k < 2; ++k) dst[n][k] = *(const PG8_LAS bf16x8*)(lds + PG8_SB(b, h) + boff + n * 2048 + k * 1024); } while (0)
#define PG8_MMA(ai, bj, At, Bt) do { __builtin_amdgcn_s_setprio(1); _Pragma("unroll") for (int m = 0; m < 4; ++m) _Pragma("unroll") for (int n = 0; n < 2; ++n) _Pragma("unroll") for (int k = 0; k < 2; ++k) \
        acc[ai][bj][m][n] = __builtin_amdgcn_mfma_f32_16x16x32_bf16(Bt[n][k], At[m][k], acc[ai][bj][m][n], 0, 0, 0); __builtin_amdgcn_s_setprio(0); } while (0)
#define PG8_WAIT_V(n) asm volatile("s_waitcnt vmcnt(" #n ")" ::: "memory")
#define PG8_WAIT_L(n) asm volatile("s_waitcnt lgkmcnt(" #n ")" ::: "memory")
#define PG8_BAR __builtin_amdgcn_s_barrier()
#define PG8_SCHED __builtin_amdgcn_sched_barrier(0)
    Unit cur, nxt; int ui = 0;
    if (!S.next(0, cur)) return;
    f32x4 acc[2][2][4][2];
#pragma unroll
    for (int a = 0; a < 2; ++a)
#pragma unroll
        for (int b = 0; b < 2; ++b)
#pragma unroll
            for (int m = 0; m < 4; ++m)
#pragma unroll
                for (int n = 0; n < 2; ++n) acc[a][b][m][n] = (f32x4){0.f, 0.f, 0.f, 0.f};
    bf16x8 At[4][2], B0[2][2], B1[2][2];
    const char* cA = (const char*)(cur.w ? g.A2 : g.A) + (size_t)cur.pm * tstep; const char* cB = (const char*)(cur.w ? g.Bt2 : g.Bt) + (size_t)cur.pn * tstep;
    S.a_ready(cur);
    if constexpr (SP2) {
        PG8_STAGE(PG8_SB(0, 0), cB, voffB); PG8_STAGE(PG8_SB(0, 1), cB + hstep, voffB); PG8_STAGE(PG8_SA(0, 0), cA, voffA); PG8_STAGE(PG8_SA(0, 1), cA + hstep, voffA);
        if (wr == 1) PG8_BAR;
        PG8_WAIT_V(2); PG8_BAR;
        PG8_STAGE(PG8_SB(1, 0), cB + kstep, voffB); PG8_STAGE(PG8_SA(1, 0), cA + kstep, voffA); PG8_STAGE(PG8_SB(1, 1), cB + hstep + kstep, voffB);
        PG8_WAIT_V(6); PG8_BAR;
    } else {
        PG8_STAGE(PG8_SB(0, 0), cB, voffB); PG8_STAGE(PG8_SA(0, 0), cA, voffA); PG8_STAGE(PG8_SB(0, 1), cB + hstep, voffB); PG8_STAGE(PG8_SA(0, 1), cA + hstep, voffA);
        if (wr == 1) PG8_BAR;
        PG8_WAIT_V(4); PG8_BAR;
        PG8_STAGE(PG8_SB(1, 0), cB + kstep, voffB); PG8_STAGE(PG8_SA(1, 0), cA + kstep, voffA); PG8_STAGE(PG8_SB(1, 1), cB + hstep + kstep, voffB);
        PG8_WAIT_V(6); PG8_BAR;
    }
    for (;;) {
        const bool has_next = S.next(ui + 1, nxt);
        const char* nA = has_next ? (const char*)(nxt.w ? g.A2 : g.A) + (size_t)nxt.pm * tstep : cA; const char* nB = has_next ? (const char*)(nxt.w ? g.Bt2 : g.Bt) + (size_t)nxt.pn * tstep : cB;
        for (int t = 0; t < nt; t += 2) {
            const bool last = (t == nt - 2);
            const char* a1 = cA + (size_t)(t + 1) * kstep;
            const char* a2 = last ? nA : cA + (size_t)(t + 2) * kstep; const char* b2 = last ? nB : cB + (size_t)(t + 2) * kstep;
            const char* a3 = a2 + kstep; const char* b3 = b2 + kstep;
            if (last && has_next) S.a_ready(nxt);
            if constexpr (SP2) {
            PG8_LDB(B0, 0, 0); PG8_LDB(B1, 0, 1); PG8_SCHED; PG8_LDA(At, 0, 0); PG8_STAGE(PG8_SA(1, 1), a1 + hstep, voffA);
            PG8_WAIT_V(8); PG8_WAIT_L(0); PG8_BAR; PG8_MMA(0, 0, At, B0); PG8_MMA(0, 1, At, B1); PG8_BAR; PG8_SCHED;
            PG8_LDA(At, 0, 1); PG8_STAGE(PG8_SB(0, 0), b2, voffB); PG8_STAGE(PG8_SB(0, 1), b2 + hstep, voffB); PG8_STAGE(PG8_SA(0, 0), a2, voffA);
            PG8_WAIT_V(8); PG8_WAIT_L(0); PG8_BAR; PG8_MMA(1, 0, At, B0); PG8_MMA(1, 1, At, B1); PG8_BAR; PG8_SCHED;
            PG8_LDB(B0, 1, 0); PG8_LDB(B1, 1, 1); PG8_SCHED; PG8_LDA(At, 1, 0); PG8_STAGE(PG8_SA(0, 1), a2 + hstep, voffA);
            PG8_WAIT_V(8); PG8_WAIT_L(0); PG8_BAR; PG8_MMA(0, 0, At, B0); PG8_MMA(0, 1, At, B1); PG8_BAR; PG8_SCHED;
            PG8_LDA(At, 1, 1); PG8_STAGE(PG8_SB(1, 0), b3, voffB); PG8_STAGE(PG8_SB(1, 1), b3 + hstep, voffB); PG8_STAGE(PG8_SA(1, 0), a3, voffA);
            PG8_WAIT_V(8); PG8_WAIT_L(0); PG8_BAR; PG8_MMA(1, 0, At, B0); PG8_MMA(1, 1, At, B1); PG8_BAR; PG8_SCHED;
            } else {
            PG8_LDB(B0, 0, 0); PG8_SCHED; PG8_LDA(At, 0, 0); PG8_STAGE(PG8_SA(1, 1), a1 + hstep, voffA);
            PG8_WAIT_L(8); PG8_BAR; PG8_WAIT_L(0); PG8_MMA(0, 0, At, B0); PG8_BAR; PG8_SCHED;
            PG8_LDB(B1, 0, 1); PG8_STAGE(PG8_SB(0, 0), b2, voffB);
            PG8_BAR; PG8_WAIT_L(0); PG8_MMA(0, 1, At, B1); PG8_BAR;
            PG8_LDA(At, 0, 1); PG8_STAGE(PG8_SA(0, 0), a2, voffA);
            PG8_BAR; PG8_WAIT_L(0); PG8_MMA(1, 0, At, B0); PG8_BAR; PG8_SCHED;
            PG8_STAGE(PG8_SB(0, 1), b2 + hstep, voffB);
            PG8_WAIT_V(6); PG8_BAR; PG8_MMA(1, 1, At, B1); PG8_BAR;
            PG8_LDB(B0, 1, 0); PG8_SCHED; PG8_LDA(At, 1, 0); PG8_STAGE(PG8_SA(0, 1), a2 + hstep, voffA);
            PG8_WAIT_L(8); PG8_BAR; PG8_WAIT_L(0); PG8_MMA(0, 0, At, B0); PG8_BAR; PG8_SCHED;
            PG8_LDB(B1, 1, 1); PG8_STAGE(PG8_SB(1, 0), b3, voffB);
            PG8_BAR; PG8_WAIT_L(0); PG8_MMA(0, 1, At, B1); PG8_BAR;
            PG8_LDA(At, 1, 1); PG8_STAGE(PG8_SA(1, 0), a3, voffA);
            PG8_BAR; PG8_WAIT_L(0); PG8_MMA(1, 0, At, B0); PG8_BAR; PG8_SCHED;
            PG8_STAGE(PG8_SB(1, 1), b3 + hstep, voffB);
            PG8_WAIT_V(6); PG8_BAR; PG8_MMA(1, 1, At, B1); PG8_BAR;
            }
        }
        if constexpr (ALIGN_EPI) { if (wr == 0) PG8_BAR; }
        if constexpr (!Epi::AFTER_DRAIN) { E(acc, cur, wr, wc, fr, fq); S.done(cur); }
        if (!has_next) break;
#pragma unroll
        for (int a = 0; a < 2; ++a)
#pragma unroll
            for (int b = 0; b < 2; ++b)
#pragma unroll
                for (int m = 0; m < 4; ++m)
#pragma unroll
                    for (int n = 0; n < 2; ++n) acc[a][b][m][n] = (f32x4){0.f, 0.f, 0.f, 0.f};
        cur = nxt; cA = nA; cB = nB; ++ui;
        if constexpr (ALIGN_EPI) { if (wr == 1) PG8_BAR; }
    }
    PG8_WAIT_V(0);
    if constexpr (!ALIGN_EPI) { if (wr == 0) PG8_BAR; }
    PG8_BAR;
    if constexpr (Epi::AFTER_DRAIN) { E.fused(acc, cur, wr, wc, fr, fq, lds, wid, lane); S.done(cur); }
#undef PG8_SA
#undef PG8_SB
#undef PG8_STAGE
#undef PG8_LDA
#undef PG8_LDB
#undef PG8_MMA
#undef PG8_WAIT_V
#undef PG8_WAIT_L
#undef PG8_BAR
#undef PG8_SCHED
}
}

constexpr int BATCH = 16, SEQ = 2048, DM = 1024, MTOK = BATCH * SEQ, NQKV = 1536, FF = 2816, NH = 16, NKV = 4, HD = 64;
constexpr float RMS_EPS = 1e-6f, LOG2E = 1.4426950408889634f;
constexpr int NWAVES = 8;
#define LAS __attribute__((address_space(3)))
typedef unsigned short bf16;
typedef float f32x4 __attribute__((ext_vector_type(4)));
typedef float f32x16 __attribute__((ext_vector_type(16)));
typedef unsigned u32x4 __attribute__((ext_vector_type(4)));
typedef unsigned u32x2 __attribute__((ext_vector_type(2)));
typedef short bf16x8 __attribute__((ext_vector_type(8)));

constexpr size_t MiB = 1u << 20;
constexpr size_t WS_WQKV = 0, WS_WO = 3 * MiB, WS_WIN = 5 * MiB, WS_WOUT = 11 * MiB, WS_WGU = 13 * MiB  , WS_WD = 35 * MiB  ;
constexpr size_t WS_ROPE = 46 * MiB;
constexpr size_t WS_CTL = 46 * MiB + 768 * 1024;
constexpr size_t WS_XNB = 47 * MiB;
constexpr size_t WS_GH = 48 * MiB;
constexpr size_t WS_XN = 52 * MiB;
constexpr size_t WS_Y = 116 * MiB;
constexpr size_t WS_ACT = 180 * MiB;
constexpr size_t WS_Q = 180 * MiB, WS_K = 244 * MiB, WS_VT = 260 * MiB;
constexpr size_t WS_P = 180 * MiB, WS_Y2 = 244 * MiB;
constexpr size_t WS_END = 356 * MiB;

constexpr int LDS_BYTES = 147456, LDS_BARST = 131072 + 64, LDS_XCH = 131072 + 1024;
constexpr int BAR_WORDS = 3456;

__device__ __forceinline__ unsigned f2bf(float f) { unsigned u = __builtin_bit_cast(unsigned, f); return (u + 0x7fffu + ((u >> 16) & 1u)) >> 16; }
__device__ __forceinline__ unsigned pk2(float lo, float hi) { return f2bf(lo) | (f2bf(hi) << 16); }
__device__ __forceinline__ float wave_sum(float v) {
#pragma unroll
    for (int o = 1; o < 64; o <<= 1) v += __shfl_xor(v, o);
    return v;
}

#define RLX_AGENT __ATOMIC_RELAXED, __HIP_MEMORY_SCOPE_AGENT
#define XB_TMO      128
#define XB_XCNT(j)  (256  + 64 * (j))
#define XB_XSUB(j)  (1280 + 64 * (j))
#define XB_XGEN(j)  (2304 + 64 * (j))
#define XB_TOP      3328
#define XB_TOPGEN   3392
#define XCD_BAR_WORDS 3456
#define XB_SPIN_CAP (1u << 18)

__device__ __forceinline__ unsigned xb_ld(unsigned* p)              { return __hip_atomic_load(p, __ATOMIC_RELAXED, __HIP_MEMORY_SCOPE_AGENT); }
__device__ __forceinline__ unsigned xb_add(unsigned* p, unsigned v) { return __hip_atomic_fetch_add(p, v, __ATOMIC_RELAXED, __HIP_MEMORY_SCOPE_AGENT); }
__device__ __forceinline__ unsigned xb_xcc_id() { return (unsigned)__builtin_amdgcn_s_getreg((3 << 11) | 20) & 0xFu; }
#define XB_SPIN(cond, bar) do { unsigned _sp = 0; while (cond) { __builtin_amdgcn_s_sleep(1); \
    if ((++_sp & 255u) == 0u) { if (xb_ld(&(bar)[XB_TMO])) break; if (_sp > XB_SPIN_CAP) { atomicAdd(&(bar)[XB_TMO], 1u); break; } } } } while (0)

struct XcdBarrier {
    unsigned* bar; unsigned x;
    volatile LAS unsigned* st;
};

__device__ __forceinline__ XcdBarrier xcd_barrier_post(unsigned* bar, volatile LAS unsigned* st) {
    XcdBarrier b; b.bar = bar; b.x = xb_xcc_id(); b.st = st;
    if (threadIdx.x == 0) (void)xb_add(&bar[XB_XCNT(b.x)], 1u);
    return b;
}
__device__ __forceinline__ void xcd_barrier_complete(unsigned* bar, unsigned x, unsigned& nloc, unsigned& nx) {
    const unsigned G = gridDim.x * gridDim.y * gridDim.z;
    unsigned sum, cnt, mine, sp = 0u;
    for (;;) {
        sum = 0u; cnt = 0u; mine = 0u;
#pragma unroll
        for (unsigned j = 0; j < 16; ++j) { const unsigned c = xb_ld(&bar[XB_XCNT(j)]); sum += c; cnt += (c > 0u) ? 1u : 0u; mine = (j == x) ? c : mine; }
        if (sum == G) break;
        __builtin_amdgcn_s_sleep(1);
        if ((++sp & 255u) == 0u) { if (xb_ld(&bar[XB_TMO])) break; if (sp > XB_SPIN_CAP) { atomicAdd(&bar[XB_TMO], 1u); break; } }
    }
    nloc = mine > 0u ? mine : 1u; nx = cnt > 0u ? cnt : 1u;
}

__device__ __forceinline__ void xcd_barrier(const XcdBarrier& b) {
    asm volatile("s_waitcnt vmcnt(0)" ::: "memory");
    __syncthreads();
    if (threadIdx.x == 0) {
        unsigned* bar = b.bar;
        __builtin_amdgcn_s_waitcnt(0);
        unsigned nloc = b.st[0], nx = b.st[1];
        if (nloc == 0u) { xcd_barrier_complete(bar, b.x, nloc, nx); b.st[0] = nloc; b.st[1] = nx; }
        const unsigned old = xb_add(&bar[XB_XSUB(b.x)], 1u);
        const unsigned gen = old / nloc;
        if (old + 1u == (gen + 1u) * nloc) {
            __builtin_amdgcn_fence(__ATOMIC_RELEASE, "agent");
            asm volatile("s_waitcnt vmcnt(0)" ::: "memory");
            const unsigned og = xb_add(&bar[XB_TOP], 1u);
            const unsigned tg = og / nx;
            if (og + 1u == (tg + 1u) * nx) xb_add(&bar[XB_TOPGEN], 1u);
            else XB_SPIN(xb_ld(&bar[XB_TOPGEN]) == tg, bar);
            __builtin_amdgcn_fence(__ATOMIC_ACQUIRE, "agent");
            xb_add(&bar[XB_XGEN(b.x)], 1u);
            asm volatile("s_waitcnt vmcnt(0)" ::: "memory");
        } else {
            XB_SPIN(xb_ld(&bar[XB_XGEN(b.x)]) == gen, bar);
            __builtin_amdgcn_fence(__ATOMIC_ACQUIRE, "agent");
            asm volatile("s_waitcnt vmcnt(0)" ::: "memory");
        }
    }
    __syncthreads();
}

namespace att {
constexpr int KSTR = 144, VSTR = 776, LDS_K = 0, LDS_V = 384 * KSTR;
__device__ __forceinline__ int crow(int r, int hi) { return (r & 3) + 8 * (r >> 2) + 4 * hi; }
#define MFMA32(a, b, c) __builtin_amdgcn_mfma_f32_32x32x16_bf16((a), (b), (c), 0, 0, 0)
__device__ __forceinline__ void attn_phase(LAS unsigned char* lds, bf16* Q, const bf16* Kg, const bf16* Vt, const float* sink) {
    int tid_ = threadIdx.x; asm volatile("" : "+v"(tid_));
    const int tid = tid_, lane = tid & 63, wid = __builtin_amdgcn_readfirstlane(tid >> 6), i32 = lane & 31, hi = lane >> 5;
    for (int u = blockIdx.x; u < BATCH * 16 * NKV; u += gridDim.x) {
        const int kvh = u & 3, blk = (u >> 2) & 15, b = u >> 6;
        const int tlo = blk == 0 ? 128 : 0, thi = blk == 15 ? 256 : 384;
        const long tok0 = (long)b * SEQ + blk * 128 - 128;
#pragma unroll
        for (int j = 0; j < 6; ++j) { const int id = tid + 512 * j, t = id >> 3, c = id & 7;
            if (t >= tlo && t < thi) { const u32x4 v = *(const u32x4*)(Kg + (tok0 + t) * 256 + kvh * 64 + c * 8); *(LAS u32x4*)(lds + LDS_K + t * KSTR + c * 16) = v; } }
#pragma unroll
        for (int j = 0; j < 6; ++j) { const int id = tid + 512 * j, d = id / 48, ch = id % 48, t = ch * 8;
            if (t >= tlo && t < thi) { const u32x4 v = *(const u32x4*)(Vt + (size_t)(kvh * 64 + d) * MTOK + tok0 + t);
                LAS u32x2* p = (LAS u32x2*)(lds + LDS_V + d * VSTR + ch * 16); p[0] = (u32x2){v.x, v.y}; p[1] = (u32x2){v.z, v.w}; } }
        __syncthreads();
        const int g = wid >> 1, r0 = (wid & 1) * 64, h = kvh * 4 + g;
        const long qrow0 = (long)b * SEQ + blk * 128 + r0;
        bf16x8 qf[2][4];
#pragma unroll
        for (int qt = 0; qt < 2; ++qt)
#pragma unroll
            for (int dc = 0; dc < 4; ++dc) qf[qt][dc] = *(const bf16x8*)(Q + (qrow0 + qt * 32 + i32) * 1024 + h * 64 + dc * 16 + hi * 8);
        f32x16 o[2][2];
#pragma unroll
        for (int a = 0; a < 2; ++a)
#pragma unroll
            for (int c = 0; c < 2; ++c)
#pragma unroll
                for (int r = 0; r < 16; ++r) o[a][c][r] = 0.f;
        const float sink2 = sink[h] * LOG2E;
        float mrun[2] = {sink2, sink2}, lrun[2] = {0.f, 0.f};
        const int ktlo = (tlo > r0 ? tlo : r0) >> 5, kthi = (thi < r0 + 320 ? thi : r0 + 320) >> 5;
        for (int kt = ktlo; kt < kthi; ++kt) {
            const int t0 = kt * 32;
            f32x16 s[2];
#pragma unroll
            for (int r = 0; r < 16; ++r) { s[0][r] = 0.f; s[1][r] = 0.f; }
#pragma unroll
            for (int dc = 0; dc < 4; ++dc) { const bf16x8 kf = *(const LAS bf16x8*)(lds + LDS_K + (t0 + i32) * KSTR + dc * 32 + hi * 16);
                s[0] = MFMA32(kf, qf[0][dc], s[0]); s[1] = MFMA32(kf, qf[1][dc], s[1]); }
            bf16x8 vf[2][2];
#pragma unroll
            for (int dt = 0; dt < 2; ++dt)
#pragma unroll
                for (int c = 0; c < 2; ++c) { const LAS unsigned char* vp = lds + LDS_V + (dt * 32 + i32) * VSTR + (t0 + 16 * c + 4 * hi) * 2;
                    const u32x2 lo = *(const LAS u32x2*)vp, hh = *(const LAS u32x2*)(vp + 16); vf[dt][c] = __builtin_bit_cast(bf16x8, (u32x4){lo.x, lo.y, hh.x, hh.y}); }
            const bool full = (t0 >= r0 + 63) && (t0 + 31 <= r0 + 256);
            if (!full) {
#pragma unroll
                for (int qt = 0; qt < 2; ++qt) { const int rq = r0 + qt * 32 + i32;
#pragma unroll
                    for (int r = 0; r < 16; ++r) { const int t = t0 + crow(r, hi); if (t < rq || t > rq + 256) s[qt][r] = -1e30f; } }
            }
#pragma unroll
            for (int qt = 0; qt < 2; ++qt) {
                float mx = s[qt][0];
#pragma unroll
                for (int r = 1; r < 16; ++r) mx = fmaxf(mx, s[qt][r]);
                mx = fmaxf(mx, __shfl_xor(mx, 32));
                const float mn = fmaxf(mrun[qt], mx), alpha = __builtin_amdgcn_exp2f(mrun[qt] - mn);
                mrun[qt] = mn; float ls = 0.f;
#pragma unroll
                for (int r = 0; r < 16; ++r) { const float p = __builtin_amdgcn_exp2f(s[qt][r] - mn); s[qt][r] = p; ls += p; }
                lrun[qt] = lrun[qt] * alpha + ls;
#pragma unroll
                for (int r = 0; r < 16; ++r) { o[qt][0][r] *= alpha; o[qt][1][r] *= alpha; }
                u32x4 p0, p1;
                p0.x = pg8::cvt_pk_bf16(s[qt][0], s[qt][1]); p0.y = pg8::cvt_pk_bf16(s[qt][2], s[qt][3]); p0.z = pg8::cvt_pk_bf16(s[qt][4], s[qt][5]); p0.w = pg8::cvt_pk_bf16(s[qt][6], s[qt][7]);
                p1.x = pg8::cvt_pk_bf16(s[qt][8], s[qt][9]); p1.y = pg8::cvt_pk_bf16(s[qt][10], s[qt][11]); p1.z = pg8::cvt_pk_bf16(s[qt][12], s[qt][13]); p1.w = pg8::cvt_pk_bf16(s[qt][14], s[qt][15]);
                const bf16x8 pf0 = __builtin_bit_cast(bf16x8, p0), pf1 = __builtin_bit_cast(bf16x8, p1);
#pragma unroll
                for (int dt = 0; dt < 2; ++dt) { o[qt][dt] = MFMA32(vf[dt][0], pf0, o[qt][dt]); o[qt][dt] = MFMA32(vf[dt][1], pf1, o[qt][dt]); }
            }
        }
#pragma unroll
        for (int qt = 0; qt < 2; ++qt) {
            const float lt = lrun[qt] + __shfl_xor(lrun[qt], 32) + __builtin_amdgcn_exp2f(sink2 - mrun[qt]);
            const float inv = 1.0f / lt;
            bf16* orow = Q + (qrow0 + qt * 32 + i32) * 1024 + h * 64 + 4 * hi;
#pragma unroll
            for (int dt = 0; dt < 2; ++dt)
#pragma unroll
                for (int r4 = 0; r4 < 4; ++r4) { u32x2 w; w.x = pg8::cvt_pk_bf16(o[qt][dt][4 * r4] * inv, o[qt][dt][4 * r4 + 1] * inv); w.y = pg8::cvt_pk_bf16(o[qt][dt][4 * r4 + 2] * inv, o[qt][dt][4 * r4 + 3] * inv);
                    *(u32x2*)(orow + dt * 32 + 8 * r4) = w; }
        }
        __syncthreads();
    }
}
}

__device__ __forceinline__ void row_pass(const float* rin, const bf16* y, const float* gpost, const float* gnext, float* rout, bf16* xn, bf16* xnb) {
    int tid_ = threadIdx.x; asm volatile("" : "+v"(tid_)); const int lane = tid_ & 63, wave = __builtin_amdgcn_readfirstlane(tid_ >> 6);
    const int gw = blockIdx.x * NWAVES + wave, NGW = gridDim.x * NWAVES;
    for (int row = gw; row < MTOK; row += NGW) {
        const size_t off = (size_t)row * DM + 4 * lane;
        f32x4 yv[4], hv[4]; float ss = 0.f;
#pragma unroll
        for (int j = 0; j < 4; ++j) { const u32x2 w = *(const u32x2*)(y + off + 256 * j);
            yv[j] = (f32x4){__uint_as_float(w.x << 16), __uint_as_float(w.x & 0xffff0000u), __uint_as_float(w.y << 16), __uint_as_float(w.y & 0xffff0000u)};
            ss += (yv[j][0] * yv[j][0] + yv[j][1] * yv[j][1]) + (yv[j][2] * yv[j][2] + yv[j][3] * yv[j][3]); }
        const float rstd = 1.0f / sqrtf(wave_sum(ss) * (1.0f / DM) + RMS_EPS);
        float s2 = 0.f;
#pragma unroll
        for (int j = 0; j < 4; ++j) { const f32x4 g = *(const f32x4*)(gpost + 4 * lane + 256 * j), r = *(const f32x4*)(rin + off + 256 * j);
            hv[j] = r + (yv[j] * rstd) * g; *(f32x4*)(rout + off + 256 * j) = hv[j];
            s2 += (hv[j][0] * hv[j][0] + hv[j][1] * hv[j][1]) + (hv[j][2] * hv[j][2] + hv[j][3] * hv[j][3]); }
        if (gnext) {
            const float rstd2 = 1.0f / sqrtf(wave_sum(s2) * (1.0f / DM) + RMS_EPS);
#pragma unroll
            for (int j = 0; j < 4; ++j) { const f32x4 g = *(const f32x4*)(gnext + 4 * lane + 256 * j); const f32x4 v = (hv[j] * rstd2) * g;
                u32x2 w; w.x = pk2(v[0], v[1]); w.y = pk2(v[2], v[3]); *(u32x2*)(xn + off + 256 * j) = w;
                const int rl = row & 255;
                if (rl == 255 && row + 1 < MTOK) *(u32x2*)(xnb + (size_t)(2 * ((row + 1) >> 8)) * DM + 4 * lane + 256 * j) = w;
                if (rl == 0) *(u32x2*)(xnb + (size_t)(2 * (row >> 8) + 1) * DM + 4 * lane + 256 * j) = w; }
        }
    }
}
__device__ __forceinline__ void norm_rows(const float* x, const float* g, bf16* xn) {
    int tid_ = threadIdx.x; asm volatile("" : "+v"(tid_)); const int lane = tid_ & 63, wave = __builtin_amdgcn_readfirstlane(tid_ >> 6);
    const int gw = blockIdx.x * NWAVES + wave, NGW = gridDim.x * NWAVES;
    for (int row = gw; row < MTOK; row += NGW) {
        const size_t off = (size_t)row * DM + 4 * lane;
        f32x4 v[4]; float ss = 0.f;
#pragma unroll
        for (int j = 0; j < 4; ++j) { v[j] = *(const f32x4*)(x + off + 256 * j); ss += (v[j][0] * v[j][0] + v[j][1] * v[j][1]) + (v[j][2] * v[j][2] + v[j][3] * v[j][3]); }
        const float rstd = 1.0f / sqrtf(wave_sum(ss) * (1.0f / DM) + RMS_EPS);
#pragma unroll
        for (int j = 0; j < 4; ++j) { const f32x4 gg = *(const f32x4*)(g + 4 * lane + 256 * j); const f32x4 o = (v[j] * rstd) * gg;
            u32x2 w; w.x = pk2(o[0], o[1]); w.y = pk2(o[2], o[3]); *(u32x2*)(xn + off + 256 * j) = w; }
    }
}

__device__ __forceinline__ int map_col(int mode, int n) {
    if (mode == 1) {
        if (n >= 1280) return n;
        const int p = n & 63, j = p >> 3, e = p & 7; return (n & ~63) + (e < 4 ? 4 * j + e : 32 + 4 * j + (e - 4));
    }
    if (mode == 2) {
        if (n >= 2048) return n - 2048;
        const int j = n >> 8, hsel = (n >> 7) & 1, i = n & 127; return 1024 + hsel * 1024 + 128 * j + i;
    }
    if (mode == 3) { const int j = n >> 8, hsel = (n >> 7) & 1, i = n & 127; return hsel * FF + 128 * j + i; }
    return n;
}
__device__ __forceinline__ void transpose_item(const float* W, int K, int N, bf16* WT, int mode, LAS float* scr, int item, int lane) {
    const int nblk = N / 32, kb = item / nblk, nb = item % nblk, k0 = 64 * kb, n0 = 32 * nb;
    const int src = map_col(mode, n0 + (lane & 31));
#pragma unroll 8
    for (int i = 0; i < 32; ++i) { const int kk = 2 * i + (lane >> 5); scr[kk * 33 + (lane & 31)] = W[(size_t)(k0 + kk) * N + src]; }
    asm volatile("s_waitcnt lgkmcnt(0)" ::: "memory");
    const int c = lane & 7;
#pragma unroll
    for (int j = 0; j < 4; ++j) { const int n = (lane >> 3) + 8 * j; const LAS float* s = scr + (8 * c) * 33 + n;
        u32x4 o; o.x = pk2(s[0 * 33], s[1 * 33]); o.y = pk2(s[2 * 33], s[3 * 33]); o.z = pk2(s[4 * 33], s[5 * 33]); o.w = pk2(s[6 * 33], s[7 * 33]);
        *(u32x4*)(WT + (size_t)(n0 + n) * K + k0 + 8 * c) = o; }
    asm volatile("s_waitcnt lgkmcnt(0)" ::: "memory");
}
__device__ const float INV_FREQ[32] = {1.000000000e+00f, 7.498942614e-01f, 5.623413324e-01f, 4.216965139e-01f, 3.162277639e-01f, 2.371373773e-01f, 1.778279394e-01f, 1.333521307e-01f, 1.000000015e-01f, 7.498941571e-02f, 5.623413250e-02f, 4.216965288e-02f, 3.162277490e-02f, 2.371373773e-02f, 1.778279431e-02f, 1.333521493e-02f, 9.999999776e-03f, 7.498941850e-03f, 5.623413250e-03f, 4.216964822e-03f, 3.162277630e-03f, 2.371373586e-03f, 1.778279431e-03f, 1.333521446e-03f, 1.000000047e-03f, 7.498942432e-04f, 5.623413017e-04f, 4.216965172e-04f, 3.162277571e-04f, 2.371373703e-04f, 1.778279402e-04f, 1.333521504e-04f};
__device__ __forceinline__ void sincos_f64(float angf, float& c, float& s) {
    const double a = (double)angf, k = __builtin_rint(a * 0.63661977236758134308);
    double r = __builtin_fma(-k, 1.57079632679489655800e+00, a); r = __builtin_fma(-k, 6.12323399573676603587e-17, r);
    const double r2 = r * r;
    double sp = -1.0 / 1307674368000.0; sp = sp * r2 + 1.0 / 6227020800.0; sp = sp * r2 - 1.0 / 39916800.0; sp = sp * r2 + 1.0 / 362880.0; sp = sp * r2 - 1.0 / 5040.0; sp = sp * r2 + 1.0 / 120.0; sp = sp * r2 - 1.0 / 6.0; sp = sp * r2 + 1.0;
    double cp = 1.0 / 20922789888000.0; cp = cp * r2 - 1.0 / 87178291200.0; cp = cp * r2 + 1.0 / 479001600.0; cp = cp * r2 - 1.0 / 3628800.0; cp = cp * r2 + 1.0 / 40320.0; cp = cp * r2 - 1.0 / 720.0; cp = cp * r2 + 1.0 / 24.0; cp = cp * r2 - 0.5; cp = cp * r2 + 1.0;
    const double sr = sp * r, cr = cp; const int q = (int)((long long)k & 3);
    const double cc = (q == 0) ? cr : (q == 1) ? -sr : (q == 2) ? -cr : sr;
    const double sv = (q == 0) ? sr : (q == 1) ? cr : (q == 2) ? -sr : -cr;
    c = (float)cc; s = (float)sv;
}

#ifndef PHASES
#define PHASES 0xffff
#endif
#define PH(k) ((PHASES >> (k)) & 1)
struct Args { const float* in[12]; float* out; unsigned char* ws; };

typedef const Args __attribute__((address_space(4)))* ArgsP;
#define PTRS ArgsP ap_ = (ArgsP)__builtin_amdgcn_kernarg_segment_ptr(); asm volatile("" : "+s"(ap_)); \
    unsigned char* ws = ap_->ws; (void)ws; \
    const float* x = ap_->in[0]; const int* positions = (const int*)ap_->in[1]; const float* w_qkv = ap_->in[2]; const float* sink = ap_->in[3]; const float* w_o = ap_->in[4]; \
    const float* w_in = ap_->in[5]; const float* conv_w = ap_->in[6]; const float* w_out = ap_->in[7]; const float* gains = ap_->in[8]; const float* w_gu = ap_->in[9]; \
    const float* ffn_cw = ap_->in[10]; const float* w_dn = ap_->in[11]; float* out = ap_->out; \
    bf16* Wqkv_t = (bf16*)(ws + WS_WQKV); bf16* Wo_t = (bf16*)(ws + WS_WO); bf16* Win_t = (bf16*)(ws + WS_WIN); bf16* Wout_t = (bf16*)(ws + WS_WOUT); \
    bf16* Wgu_t = (bf16*)(ws + WS_WGU); bf16* Wd_t = (bf16*)(ws + WS_WD); float* rcos = (float*)(ws + WS_ROPE); float* rsin = rcos + SEQ * 32; \
    bf16* XN = (bf16*)(ws + WS_XN); bf16* XNB = (bf16*)(ws + WS_XNB); bf16* GH = (bf16*)(ws + WS_GH); (void)XNB; (void)GH; bf16* Y = (bf16*)(ws + WS_Y); bf16* ACT = (bf16*)(ws + WS_ACT); \
    bf16* QB = (bf16*)(ws + WS_Q); bf16* KB = (bf16*)(ws + WS_K); bf16* VT = (bf16*)(ws + WS_VT); bf16* PB = (bf16*)(ws + WS_P); bf16* Y2 = (bf16*)(ws + WS_Y2); \
    (void)x; (void)positions; (void)w_qkv; (void)sink; (void)w_o; (void)w_in; (void)conv_w; (void)w_out; (void)gains; (void)w_gu; (void)ffn_cw; (void)w_dn; (void)out; \
    (void)Wqkv_t; (void)Wo_t; (void)Win_t; (void)Wout_t; (void)Wgu_t; (void)Wd_t; (void)rcos; (void)rsin; (void)XN; (void)Y; (void)ACT; (void)QB; (void)KB; (void)VT; (void)PB; (void)Y2; \
    const int G = gridDim.x; (void)G

__global__ void __launch_bounds__(NWAVES * 64, 2) fwd_megakernel(Args args) {
    extern __shared__ __attribute__((aligned(16))) unsigned char lds_raw[];
    LAS unsigned char* lds = (LAS unsigned char*)lds_raw;
    cg::grid_group grid = cg::this_grid();
#define SYNC() do { ArgsP bp_ = (ArgsP)__builtin_amdgcn_kernarg_segment_ptr(); XcdBarrier b_; b_.bar = (unsigned*)(bp_->ws + WS_CTL); b_.x = xb_xcc_id(); b_.st = (volatile LAS unsigned*)(lds + LDS_BARST); xcd_barrier(b_); } while (0)
    if (threadIdx.x == 0) { ((volatile LAS unsigned*)(lds + LDS_BARST))[0] = 0u; ((volatile LAS unsigned*)(lds + LDS_BARST))[1] = 0u; }
    if (blockIdx.x == 0) { unsigned* ctl = (unsigned*)(args.ws + WS_CTL); for (int i = threadIdx.x; i < BAR_WORDS; i += NWAVES * 64) ctl[i] = 0u; }
    __syncthreads();

    if (PH(0)) {
        PTRS;
        int tid_ = threadIdx.x; asm volatile("" : "+v"(tid_)); const int tid = tid_, lane = tid & 63, wave = __builtin_amdgcn_readfirstlane(tid >> 6);
        LAS float* scr = (LAS float*)(lds + wave * 16384);
        const int gw = blockIdx.x * NWAVES + wave, NGW = G * NWAVES;
        constexpr int I_QKV = 16 * (NQKV / 32), I_O = 16 * 32, I_IN = 16 * 96, I_OUT = 16 * 32, I_GU = 16 * (2 * FF / 32), I_D = (FF / 64) * 32;
        constexpr int NITEMS = I_QKV + I_O + I_IN + I_OUT + 2 * I_GU + 2 * I_D;
        for (int it = gw; it < NITEMS; it += NGW) {
            int r = it;
            if (r < I_QKV) { transpose_item(w_qkv, DM, NQKV, Wqkv_t, 1, scr, r, lane); continue; } r -= I_QKV;
            if (r < I_O) { transpose_item(w_o, DM, DM, Wo_t, 0, scr, r, lane); continue; } r -= I_O;
            if (r < I_IN) { transpose_item(w_in, DM, 3 * DM, Win_t, 2, scr, r, lane); continue; } r -= I_IN;
            if (r < I_OUT) { transpose_item(w_out, DM, DM, Wout_t, 0, scr, r, lane); continue; } r -= I_OUT;
            if (r < I_GU) { transpose_item(w_gu, DM, 2 * FF, Wgu_t, 3, scr, r, lane); continue; } r -= I_GU;
            if (r < I_GU) { transpose_item(w_gu + (size_t)DM * 2 * FF, DM, 2 * FF, Wgu_t + (size_t)2 * FF * DM, 3, scr, r, lane); continue; } r -= I_GU;
            if (r < I_D) { transpose_item(w_dn, FF, DM, Wd_t, 0, scr, r, lane); continue; } r -= I_D;
            transpose_item(w_dn + (size_t)FF * DM, FF, DM, Wd_t + (size_t)DM * FF, 0, scr, r, lane);
        }
        for (int e = blockIdx.x * (NWAVES * 64) + tid; e < SEQ * 32; e += G * NWAVES * 64) {
            const int s = e >> 5, i = e & 31; const float ang = (float)positions[s] * INV_FREQ[i];
            float c, sn; sincos_f64(ang, c, sn); rcos[e] = c; rsin[e] = sn;
        }
        norm_rows(x, gains, XN);
    }
    grid.sync();
    if (threadIdx.x == 0) (void)xb_add(&((unsigned*)(args.ws + WS_CTL))[XB_XCNT(xb_xcc_id())], 1u);
    if (PH(1)) {
        PTRS;
        pg8::Gemm g{XN, Wqkv_t, MTOK, 1280, DM, Wqkv_t + (size_t)1280 * DM, XN}; pg8::StaticOrder S; S.init(MTOK, 1280, G, (int)blockIdx.x, MTOK / 256);
        pg8::EpiQKV E{QB, (long)((WS_K - WS_Q) / 2), (long)((WS_VT - WS_Q) / 2), rcos, rsin, 0.125f * LOG2E, MTOK};
        pg8::gemm_phase<pg8::EpiQKV, pg8::StaticOrder, true, true>(lds, g, S, E);
    }
    SYNC();
    if (PH(2)) { PTRS; att::attn_phase(lds, QB, KB, VT, sink); }
    SYNC();
    if (PH(3)) {
        PTRS;
        pg8::Gemm g{QB, Wo_t, MTOK, DM, DM, nullptr, nullptr}; pg8::StaticOrder S; S.init(MTOK, DM, G, (int)blockIdx.x);
        pg8::EpiStore E{Y, DM};
        pg8::gemm_phase<pg8::EpiStore, pg8::StaticOrder, true, true>(lds, g, S, E);
    }
    SYNC();
    if (PH(4)) { PTRS; row_pass(x, Y, gains + 1 * DM, gains + 2 * DM, out, XN, XNB); }
    SYNC();
#pragma unroll 1
    for (int layer = 0; layer < 2; ++layer) {
        if (PH(5) && layer == 1) {
            if (PH(7)) {
                PTRS;
                pg8::Gemm g{XN, Win_t, MTOK, 2048, DM, nullptr, nullptr}; pg8::StaticOrder S; S.init(MTOK, 2048, G, (int)blockIdx.x);
                pg8::EpiCX E{PB};
                pg8::gemm_phase<pg8::EpiCX, pg8::StaticOrder, true, true>(lds, g, S, E);
            }
            SYNC();
            if (PH(8)) {
                PTRS;
                pg8::Gemm g{XN, Win_t + (size_t)2048 * DM, MTOK, DM, DM, nullptr, nullptr}; pg8::StaticOrder S; S.init(MTOK, DM, G, (int)blockIdx.x);
                pg8::EpiConv<0> E{PB, conv_w, Y2, DM};
                pg8::gemm_phase<pg8::EpiConv<0>, pg8::StaticOrder, true, true>(lds, g, S, E);
            }
            SYNC();
            if (PH(9)) {
                PTRS;
                pg8::Gemm g{Y2, Wout_t, MTOK, DM, DM, nullptr, nullptr}; pg8::StaticOrder S; S.init(MTOK, DM, G, (int)blockIdx.x);
                pg8::EpiStore E{Y, DM};
                pg8::gemm_phase<pg8::EpiStore, pg8::StaticOrder, true, true>(lds, g, S, E);
            }
            SYNC();
            { PTRS; row_pass(out, Y, gains + 5 * DM, gains + 6 * DM, out, XN, XNB); }
            SYNC();
        }
        if (!PH(6)) continue;
        if (PH(10)) {
            PTRS; const bf16* Wg = Wgu_t + (size_t)layer * 2 * FF * DM;
            pg8::Gemm g{XNB, Wg, 256, 2 * FF, DM, nullptr, nullptr}; pg8::StaticOrder S; S.init(256, 2 * FF, G, (int)blockIdx.x);
            pg8::EpiStore E{GH, 2 * FF};
            pg8::gemm_phase<pg8::EpiStore, pg8::StaticOrder, true, true>(lds, g, S, E);
        }
        SYNC();
        if (PH(11)) {
            PTRS; const bf16* Wg = Wgu_t + (size_t)layer * 2 * FF * DM;
            pg8::Gemm g{XN, Wg, MTOK, 2 * FF, DM, nullptr, nullptr}; pg8::StaticOrder S; S.init(MTOK, 2 * FF, G, (int)blockIdx.x);
            pg8::EpiGU E{GH, ffn_cw + (size_t)layer * 3 * FF, ACT, lds + LDS_XCH, FF};
            pg8::gemm_phase<pg8::EpiGU, pg8::StaticOrder, true, true>(lds, g, S, E);
        }
        SYNC();
        if (PH(12)) {
            PTRS; const bf16* Wd = Wd_t + (size_t)layer * DM * FF;
            pg8::Gemm g{ACT, Wd, MTOK, DM, FF, nullptr, nullptr}; pg8::StaticOrder S; S.init(MTOK, DM, G, (int)blockIdx.x);
            pg8::EpiStore E{Y, DM};
            pg8::gemm_phase<pg8::EpiStore, pg8::StaticOrder, true, true>(lds, g, S, E);
        }
        SYNC();
        { PTRS; row_pass(out, Y, gains + (layer * 4 + 3) * DM, layer == 0 ? gains + 4 * DM : nullptr, out, XN, XNB); }
        if (layer == 0) SYNC();
    }
}

extern "C" void kernel_launch(void* const* d_in, const int* in_sizes, int n_in, void* d_out, int out_size, void* d_ws, size_t ws_size, hipStream_t stream) {
    static int grid = 0;
    if (grid == 0) {
        if (n_in != 12 || in_sizes[0] != MTOK * DM || out_size != MTOK * DM || ws_size < WS_END) { fprintf(stderr, "kernel_launch: unexpected shapes / workspace (n_in %d, in0 %d, out %d, ws %zu)\n", n_in, n_in > 0 ? in_sizes[0] : -1, out_size, ws_size); grid = -1; return; }
        int dev = 0, cus = 0, per_cu = 0;
        hipGetDevice(&dev); hipDeviceGetAttribute(&cus, hipDeviceAttributeMultiprocessorCount, dev);
        if (hipFuncSetAttribute((const void*)fwd_megakernel, hipFuncAttributeMaxDynamicSharedMemorySize, LDS_BYTES) != hipSuccess) { fprintf(stderr, "kernel_launch: hipFuncSetAttribute failed\n"); grid = -1; return; }
        if (hipOccupancyMaxActiveBlocksPerMultiprocessor(&per_cu, (const void*)fwd_megakernel, NWAVES * 64, LDS_BYTES) != hipSuccess || per_cu < 1) { fprintf(stderr, "kernel_launch: occupancy query says %d\n", per_cu); per_cu = 1; }
        (void)hipGetLastError();
        grid = cus * per_cu;
    }
    if (grid < 0) return;
    Args a{};
    for (int i = 0; i < 12; ++i) a.in[i] = (const float*)d_in[i];
    a.out = (float*)d_out; a.ws = (unsigned char*)d_ws;
    void* kargs[] = {&a};
    hipError_t e = hipLaunchCooperativeKernel((const void*)fwd_megakernel, dim3(grid), dim3(NWAVES * 64), kargs, LDS_BYTES, stream);
    if (e != hipSuccess) fprintf(stderr, "kernel_launch: cooperative launch failed: %s (grid %d)\n", hipGetErrorString(e), grid);
}
```

```cpp
#include <hip/hip_runtime.h>
#include <hip/hip_cooperative_groups.h>
#include <cstdio>
#include <cstdint>
namespace cg = cooperative_groups;
namespace pg8 {
#define PG8_LAS __attribute__((address_space(3)))
typedef unsigned short bf16_t;
typedef short bf16x8 __attribute__((ext_vector_type(8)));
typedef float f32x4 __attribute__((ext_vector_type(4)));
typedef unsigned u32x4 __attribute__((ext_vector_type(4)));
constexpr int BM = 256, BK = 64, HALF = 128, HTB = HALF * BK * 2  , STAGE_BYTES = 8 * HTB, NXCD = 8, WGM = 8;

__host__ __device__ __forceinline__ int lds_byte(int r, int c) { const int st = (r >> 4) * 2 + (c >> 5), rr = r & 15, cc = c & 31, ob = rr * 64 + cc * 2; return st * 1024 + (ob ^ (((ob >> 9) & 1) << 5)); }
__host__ __device__ __forceinline__ void stage_rc(int b, int& R, int& C) { const int st = b / 1024, sb = b % 1024, swz = sb ^ (((sb >> 9) & 1) << 5); R = (st >> 1) * 16 + swz / 64; C = (st & 1) * 32 + (swz % 64) / 2; }
__host__ __device__ __forceinline__ int perm32(int rho) { const int n = rho >> 4, i = rho & 15; return 8 * (i >> 2) + 4 * n + (i & 3); }

typedef unsigned u32x2 __attribute__((ext_vector_type(2)));
struct Unit { int pm, pn, w; };
struct Gemm { const bf16_t* A; const bf16_t* Bt; int M, N, K; const bf16_t* A2; const bf16_t* Bt2; };

struct StaticOrder {
    int nM, nN, nwg, G, c, n2;
    __host__ __device__ void init(int M, int N, int G_, int c_, int n2_ = 0) { nM = M / BM; nN = N / BM; nwg = nM * nN; G = G_; c = c_; n2 = n2_; }
    __host__ __device__ bool next(int i, Unit& u) const {
        const long L = (long)i * G + c; if (L >= nwg + n2) return false;
        if (L >= nwg) { u.w = 1; u.pm = 0; u.pn = (int)(L - nwg); return true; }
        u.w = 0;
        int wgid = (int)L; { const int q = nwg / NXCD, r = nwg % NXCD, xcd = wgid % NXCD, off = wgid / NXCD; wgid = (xcd < r ? xcd * (q + 1) : r * (q + 1) + (xcd - r) * q) + off; }
        const int nig = WGM * nN, gid = wgid / nig, fm = gid * WGM, gsz = (nM - fm) < WGM ? (nM - fm) : WGM;
        u.pm = fm + ((wgid % nig) % gsz); u.pn = (wgid % nig) / gsz; return true;
    }
    __device__ __forceinline__ void a_ready(const Unit&) const {}
    __device__ __forceinline__ void done(const Unit&) const {}
};

__device__ __forceinline__ unsigned cvt_pk_bf16(float lo, float hi) { unsigned r; asm volatile("v_cvt_pk_bf16_f32 %0, %1, %2" : "=v"(r) : "v"(lo), "v"(hi)); return r; }
__device__ __forceinline__ u32x4 pack8(const f32x4 a, const f32x4 b) { u32x4 w; w.x = cvt_pk_bf16(a[0], a[1]); w.y = cvt_pk_bf16(a[2], a[3]); w.z = cvt_pk_bf16(b[0], b[1]); w.w = cvt_pk_bf16(b[2], b[3]); return w; }
__device__ __forceinline__ f32x4 bf_lo4(const u32x4 w) { return (f32x4){__uint_as_float(w.x << 16), __uint_as_float(w.x & 0xffff0000u), __uint_as_float(w.y << 16), __uint_as_float(w.y & 0xffff0000u)}; }
__device__ __forceinline__ f32x4 bf_hi4(const u32x4 w) { return (f32x4){__uint_as_float(w.z << 16), __uint_as_float(w.z & 0xffff0000u), __uint_as_float(w.w << 16), __uint_as_float(w.w & 0xffff0000u)}; }

struct EpiStore {
    static constexpr bool PERM = true, AFTER_DRAIN = false;
    bf16_t* O; int ldc;
    __device__ __forceinline__ void operator()(const f32x4 (&acc)[2][2][4][2], const Unit& u, int wr, int wc, int fr, int fq) const {
        const int row0 = u.pm * BM + wr * 64 + fr, col0 = u.pn * BM + wc * 32 + 8 * fq;
#pragma unroll
        for (int ai = 0; ai < 2; ++ai)
#pragma unroll
            for (int m = 0; m < 4; ++m) { bf16_t* rowp = O + (size_t)(row0 + ai * HALF + m * 16) * ldc + col0;
#pragma unroll
                for (int bj = 0; bj < 2; ++bj) *(u32x4*)(rowp + bj * HALF) = pack8(acc[ai][bj][m][0], acc[ai][bj][m][1]); }
    }
};

struct EpiQKV {
    static constexpr bool PERM = true, AFTER_DRAIN = false;
    bf16_t* Q; long offK, offV; const float* rcos; const float* rsin; const float* rs; float qscale; int mtok;
    __device__ __forceinline__ void operator()(const f32x4 (&acc)[2][2][4][2], const Unit& u, int wr, int wc, int fr, int fq) const {
        const bool isv = u.w != 0, isq = u.pn < 4;
        bf16_t* base = Q + (isv ? offV : (isq ? 0L : offK)); const int ldc = isv ? mtok : (isq ? 1024 : 256), colt = (isv || isq) ? u.pn * BM : 0; const float sc = (!isv && isq) ? qscale : 1.0f;
        const int i0 = 4 * ((wc & 1) * 4 + fq);
#pragma unroll
        for (int ai = 0; ai < 2; ++ai)
#pragma unroll
            for (int m = 0; m < 4; ++m) {
                const int row = u.pm * BM + ai * HALF + wr * 64 + m * 16 + fr, s = row & 2047;
                f32x4 c = (f32x4){1.f, 1.f, 1.f, 1.f}, sn = (f32x4){0.f, 0.f, 0.f, 0.f};
                if (!isv) { const float rr = rs[row] * sc; c = *(const f32x4*)(rcos + s * 32 + i0) * rr; sn = *(const f32x4*)(rsin + s * 32 + i0) * rr; }
                bf16_t* rowp = base + (size_t)row * ldc + colt + wc * 32 + 8 * fq;
#pragma unroll
                for (int bj = 0; bj < 2; ++bj) { f32x4 x1 = acc[ai][bj][m][0], x2 = acc[ai][bj][m][1];
                    if (isv) { const float* rp = rs + u.pn * BM + bj * HALF + wc * 32 + 8 * fq; x1 = x1 * *(const f32x4*)rp; x2 = x2 * *(const f32x4*)(rp + 4); }
                    *(u32x4*)(rowp + bj * HALF) = pack8(x1 * c - x2 * sn, x2 * c + x1 * sn); }
                if (m & 1) asm volatile("" ::: "memory");
            }
    }
};

struct EpiCX {
    static constexpr bool PERM = true, AFTER_DRAIN = false;
    bf16_t* P; const float* rs;
    __device__ __forceinline__ void operator()(const f32x4 (&acc)[2][2][4][2], const Unit& u, int wr, int wc, int fr, int fq) const {
        const int row0 = u.pm * BM + wr * 64 + fr, col0 = u.pn * HALF + wc * 32 + 8 * fq;
#pragma unroll
        for (int ai = 0; ai < 2; ++ai)
#pragma unroll
            for (int m = 0; m < 4; ++m) { const int row = row0 + ai * HALF + m * 16; const float r1 = rs[row], r2 = r1 * r1;
                *(u32x4*)(P + (size_t)row * 1024 + col0) = pack8(acc[ai][0][m][0] * acc[ai][1][m][0] * r2, acc[ai][0][m][1] * acc[ai][1][m][1] * r2); }
    }
};

template <int MODE> struct EpiConv {
    static constexpr bool PERM = true, AFTER_DRAIN = false;
    const bf16_t* G; const float* cw; bf16_t* O; int ldc; const float* rs;
    __device__ __forceinline__ void operator()(const f32x4 (&acc)[2][2][4][2], const Unit& u, int wr, int wc, int fr, int fq) const {
        const int row0 = u.pm * BM + wr * 64 + fr;
#pragma unroll
        for (int bj = 0; bj < 2; ++bj) {
            const int col = u.pn * BM + bj * HALF + wc * 32 + 8 * fq;
            const f32x4 w0a = *(const f32x4*)(cw + col), w0b = *(const f32x4*)(cw + col + 4);
            const f32x4 w1a = *(const f32x4*)(cw + ldc + col), w1b = *(const f32x4*)(cw + ldc + col + 4);
            const f32x4 w2a = *(const f32x4*)(cw + 2 * ldc + col), w2b = *(const f32x4*)(cw + 2 * ldc + col + 4);
#pragma unroll
            for (int ai = 0; ai < 2; ++ai)
#pragma unroll
                for (int m = 0; m < 4; ++m) {
                    const int row = row0 + ai * HALF + m * 16, s = row & 2047; const float rr = rs[row];
                    const bf16_t* gp = G + (size_t)row * ldc + col;
                    const u32x4 zc = *(const u32x4*)gp;
                    u32x4 zp = (u32x4){0u, 0u, 0u, 0u}, zn = (u32x4){0u, 0u, 0u, 0u};
                    if (s > 0) zp = *(const u32x4*)(gp - ldc);
                    if (s < 2047) zn = *(const u32x4*)(gp + ldc);
                    f32x4 za = w0a * bf_lo4(zp) + w1a * bf_lo4(zc) + w2a * bf_lo4(zn);
                    f32x4 zb = w0b * bf_hi4(zp) + w1b * bf_hi4(zc) + w2b * bf_hi4(zn);
                    f32x4 oa, ob;
                    if (MODE == 0) { oa = acc[ai][bj][m][0] * za * rr; ob = acc[ai][bj][m][1] * zb * rr; }
                    else {
#pragma unroll
                        for (int e = 0; e < 4; ++e) {
                            oa[e] = za[e] * __builtin_amdgcn_rcpf(1.0f + __builtin_amdgcn_exp2f(za[e] * -1.4426950408889634f)) * acc[ai][bj][m][0][e];
                            ob[e] = zb[e] * __builtin_amdgcn_rcpf(1.0f + __builtin_amdgcn_exp2f(zb[e] * -1.4426950408889634f)) * acc[ai][bj][m][1][e]; }
                    }
                    *(u32x4*)(O + (size_t)row * ldc + col) = pack8(oa, ob);
                    if (m & 1) asm volatile("" ::: "memory");
                }
        }
    }
};

__device__ __forceinline__ float dpp_shr1(float oldv, float src) { return __int_as_float(__builtin_amdgcn_update_dpp(__float_as_int(oldv), __float_as_int(src), 0x111, 0xf, 0xf, false)); }
__device__ __forceinline__ float dpp_shl1(float oldv, float src) { return __int_as_float(__builtin_amdgcn_update_dpp(__float_as_int(oldv), __float_as_int(src), 0x101, 0xf, 0xf, false)); }
__device__ __forceinline__ float dpp_ror1(float src) { return __int_as_float(__builtin_amdgcn_update_dpp(0, __float_as_int(src), 0x121, 0xf, 0xf, false)); }
__device__ __forceinline__ float dpp_ror15(float src) { return __int_as_float(__builtin_amdgcn_update_dpp(0, __float_as_int(src), 0x12F, 0xf, 0xf, false)); }
struct EpiGU {
    static constexpr bool PERM = true, AFTER_DRAIN = false;
    const bf16_t* GH; const float* cw; bf16_t* ACT; PG8_LAS unsigned char* xlds; int ff; const float* rs;
    __device__ __forceinline__ void operator()(f32x4 (&acc)[2][2][4][2], const Unit& u, int wr, int wc, int fr, int fq) const {
        const int colg = 32 * wc + 8 * fq, ch0 = u.pn * HALF + colg, pmod = u.pm & 7;
        { float rr[2][4];
#pragma unroll
            for (int ai = 0; ai < 2; ++ai)
#pragma unroll
                for (int m = 0; m < 4; ++m) rr[ai][m] = rs[u.pm * BM + ai * HALF + wr * 64 + m * 16 + fr];
#pragma unroll
            for (int ai = 0; ai < 2; ++ai)
#pragma unroll
                for (int m = 0; m < 4; ++m)
#pragma unroll
                    for (int bj = 0; bj < 2; ++bj)
#pragma unroll
                        for (int n = 0; n < 2; ++n) acc[ai][bj][m][n] = acc[ai][bj][m][n] * rr[ai][m]; }
        u32x4 topv = (u32x4){0u, 0u, 0u, 0u}, botv = (u32x4){0u, 0u, 0u, 0u}; float rtop = 0.f, rbot = 0.f;
        if (wr == 0 && fr == 0 && pmod != 0) { topv = *(const u32x4*)(GH + (size_t)(2 * u.pm) * (2 * ff) + u.pn * BM + colg); rtop = rs[u.pm * BM - 1]; }
        if (wr == 1 && fr == 15 && pmod != 7) { botv = *(const u32x4*)(GH + (size_t)(2 * (u.pm + 1) + 1) * (2 * ff) + u.pn * BM + colg); rbot = rs[u.pm * BM + BM]; }
        PG8_LAS float* XF = (PG8_LAS float*)xlds; PG8_LAS float* XL = XF + 4 * HALF;
        if (fr == 0) {
#pragma unroll
            for (int ai = 0; ai < 2; ++ai)
#pragma unroll
                for (int n = 0; n < 2; ++n) *(PG8_LAS f32x4*)(XF + (2 * ai + wr) * HALF + colg + 4 * n) = acc[ai][0][0][n];
        }
        if (fr == 15) {
#pragma unroll
            for (int ai = 0; ai < 2; ++ai)
#pragma unroll
                for (int n = 0; n < 2; ++n) *(PG8_LAS f32x4*)(XL + (2 * ai + wr) * HALF + colg + 4 * n) = acc[ai][0][3][n];
        }
        asm volatile("s_waitcnt lgkmcnt(0)" ::: "memory"); __builtin_amdgcn_s_barrier(); asm volatile("" ::: "memory");
#pragma unroll
        for (int ai = 0; ai < 2; ++ai) {
            const int k = 2 * ai + wr;
            f32x4 pr[2], nx[2];
#pragma unroll
            for (int n = 0; n < 2; ++n) {
                pr[n] = (k == 0) ? (n == 0 ? bf_lo4(topv) : bf_hi4(topv)) * rtop : *(const PG8_LAS f32x4*)(XL + (k - 1) * HALF + colg + 4 * n);
                nx[n] = (k == 3) ? (n == 0 ? bf_lo4(botv) : bf_hi4(botv)) * rbot : *(const PG8_LAS f32x4*)(XF + ((k + 1) & 3) * HALF + colg + 4 * n);
            }
#pragma unroll
            for (int n = 0; n < 2; ++n) {
                const f32x4 w0 = *(const f32x4*)(cw + ch0 + 4 * n), w1 = *(const f32x4*)(cw + ff + ch0 + 4 * n), w2 = *(const f32x4*)(cw + 2 * ff + ch0 + 4 * n);
#pragma unroll
                for (int m = 0; m < 4; ++m) {
                    f32x4 o;
#pragma unroll
                    for (int e = 0; e < 4; ++e) {
                        const float g = acc[ai][0][m][n][e];
                        const float oldp = (m == 0) ? pr[n][e] : dpp_ror1(acc[ai][0][m > 0 ? m - 1 : 0][n][e]);
                        const float oldn = (m == 3) ? nx[n][e] : dpp_ror15(acc[ai][0][m < 3 ? m + 1 : 3][n][e]);
                        const float P = dpp_shr1(oldp, g), N = dpp_shl1(oldn, g);
                        const float z = w0[e] * P + w1[e] * g + w2[e] * N;
                        o[e] = z * __builtin_amdgcn_rcpf(1.0f + __builtin_amdgcn_exp2f(z * -1.4426950408889634f)) * acc[ai][1][m][n][e];
                    }
                    u32x2 w; w.x = cvt_pk_bf16(o[0], o[1]); w.y = cvt_pk_bf16(o[2], o[3]);
                    *(u32x2*)(ACT + (size_t)(u.pm * BM + ai * HALF + wr * 64 + m * 16 + fr) * ff + ch0 + 4 * n) = w;
                }
            }
        }
    }
};

template <class Epi, class Sched, bool ALIGN_EPI = false, bool SP2 = false>
__device__ __forceinline__ void gemm_phase(PG8_LAS unsigned char* lds, const Gemm g, const Sched& S, const Epi& E) {
    int tid_ = threadIdx.x; asm volatile("" : "+v"(tid_));
    const int tid = tid_, wid = __builtin_amdgcn_readfirstlane(tid >> 6), lane = tid & 63, wr = wid >> 2, wc = wid & 3, fr = lane & 15, fq = lane >> 4;
    const int K = g.K, nt = K / BK;
    unsigned voffA[2], voffB[2];
#pragma unroll
    for (int i = 0; i < 2; ++i) { int R, C; stage_rc(tid * 16 + i * 8192, R, C); const int Rb = Epi::PERM ? ((R & ~31) + perm32(R & 31)) : R;
        voffA[i] = (unsigned)(R * K + C) * 2u; voffB[i] = (unsigned)(Rb * K + C) * 2u; }
    const size_t kstep = (size_t)(BK * 2);
    const size_t hstep = (size_t)HALF * K * 2;
    const size_t tstep = 2 * hstep;
    const unsigned ldsw = (unsigned)wid * 1024u;
    const int aoff = lds_byte(wr * 64 + fr, fq * 8), boff = lds_byte(wc * 32 + fr, fq * 8);
#define PG8_SA(b, h) (((b) * 2 + (h)) * HTB)
#define PG8_SB(b, h) ((4 + (b) * 2 + (h)) * HTB)
#define PG8_STAGE(bufoff, gbase, voff) do { _Pragma("unroll") for (int _i = 0; _i < 2; ++_i) \
        __builtin_amdgcn_global_load_lds((const unsigned*)((const char*)(gbase) + (voff)[_i]), (PG8_LAS unsigned*)(lds + (bufoff) + ldsw + _i * 8192), 16, 0, 0); } while (0)
#define PG8_LDA(dst, b, h) do { _Pragma("unroll") for (int m = 0; m < 4; ++m) _Pragma("unroll") for (int k = 0; k < 2; ++k) dst[m][k] = *(const PG8_LAS bf16x8*)(lds + PG8_SA(b, h) + aoff + m * 2048 + k * 1024); } while (0)
#define PG8_LDB(dst, b, h) do { _Pragma("unroll") for (int n = 0; n < 2; ++n) _Pragma("unroll") for (int k = 0; k < 2; ++k) dst[n][k] = *(const PG8_LAS bf16x8*)(lds + PG8_SB(b, h) + boff + n * 2048 + k * 1024); } while (0)
#define PG8_MMA(ai, bj, At, Bt) do { __builtin_amdgcn_s_setprio(1); _Pragma("unroll") for (int m = 0; m < 4; ++m) _Pragma("unroll") for (int n = 0; n < 2; ++n) _Pragma("unroll") for (int k = 0; k < 2; ++k) \
        acc[ai][bj][m][n] = __builtin_amdgcn_mfma_f32_16x16x32_bf16(Bt[n][k], At[m][k], acc[ai][bj][m][n], 0, 0, 0); __builtin_amdgcn_s_setprio(0); } while (0)
#define PG8_WAIT_V(n) asm volatile("s_waitcnt vmcnt(" #n ")" ::: "memory")
#define PG8_WAIT_L(n) asm volatile("s_waitcnt lgkmcnt(" #n ")" ::: "memory")
#define PG8_BAR __builtin_amdgcn_s_barrier()
#define PG8_SCHED __builtin_amdgcn_sched_barrier(0)
    Unit cur, nxt; int ui = 0;
    if (!S.next(0, cur)) return;
    f32x4 acc[2][2][4][2];
#pragma unroll
    for (int a = 0; a < 2; ++a)
#pragma unroll
        for (int b = 0; b < 2; ++b)
#pragma unroll
            for (int m = 0; m < 4; ++m)
#pragma unroll
                for (int n = 0; n < 2; ++n) acc[a][b][m][n] = (f32x4){0.f, 0.f, 0.f, 0.f};
    bf16x8 At[4][2], B0[2][2], B1[2][2];
    const char* cA = (const char*)(cur.w ? g.A2 : g.A) + (size_t)cur.pm * tstep; const char* cB = (const char*)(cur.w ? g.Bt2 : g.Bt) + (size_t)cur.pn * tstep;
    S.a_ready(cur);
    if constexpr (SP2) {
        PG8_STAGE(PG8_SB(0, 0), cB, voffB); PG8_STAGE(PG8_SB(0, 1), cB + hstep, voffB); PG8_STAGE(PG8_SA(0, 0), cA, voffA); PG8_STAGE(PG8_SA(0, 1), cA + hstep, voffA);
        if (wr == 1) PG8_BAR;
        PG8_WAIT_V(2); PG8_BAR;
        PG8_STAGE(PG8_SB(1, 0), cB + kstep, voffB); PG8_STAGE(PG8_SA(1, 0), cA + kstep, voffA); PG8_STAGE(PG8_SB(1, 1), cB + hstep + kstep, voffB);
        PG8_WAIT_V(6); PG8_BAR;
    } else {
        PG8_STAGE(PG8_SB(0, 0), cB, voffB); PG8_STAGE(PG8_SA(0, 0), cA, voffA); PG8_STAGE(PG8_SB(0, 1), cB + hstep, voffB); PG8_STAGE(PG8_SA(0, 1), cA + hstep, voffA);
        if (wr == 1) PG8_BAR;
        PG8_WAIT_V(4); PG8_BAR;
        PG8_STAGE(PG8_SB(1, 0), cB + kstep, voffB); PG8_STAGE(PG8_SA(1, 0), cA + kstep, voffA); PG8_STAGE(PG8_SB(1, 1), cB + hstep + kstep, voffB);
        PG8_WAIT_V(6); PG8_BAR;
    }
    for (;;) {
        const bool has_next = S.next(ui + 1, nxt);
        const char* nA = has_next ? (const char*)(nxt.w ? g.A2 : g.A) + (size_t)nxt.pm * tstep : cA; const char* nB = has_next ? (const char*)(nxt.w ? g.Bt2 : g.Bt) + (size_t)nxt.pn * tstep : cB;
        for (int t = 0; t < nt; t += 2) {
            const bool last = (t == nt - 2);
            const char* a1 = cA + (size_t)(t + 1) * kstep;
            const char* a2 = last ? nA : cA + (size_t)(t + 2) * kstep; const char* b2 = last ? nB : cB + (size_t)(t + 2) * kstep;
            const char* a3 = a2 + kstep; const char* b3 = b2 + kstep;
            if (last && has_next) S.a_ready(nxt);
            if constexpr (SP2) {
            PG8_LDB(B0, 0, 0); PG8_LDB(B1, 0, 1); PG8_SCHED; PG8_LDA(At, 0, 0); PG8_STAGE(PG8_SA(1, 1), a1 + hstep, voffA);
            PG8_WAIT_V(8); PG8_WAIT_L(0); PG8_BAR; PG8_MMA(0, 0, At, B0); PG8_MMA(0, 1, At, B1); PG8_BAR; PG8_SCHED;
            PG8_LDA(At, 0, 1); PG8_STAGE(PG8_SB(0, 0), b2, voffB); PG8_STAGE(PG8_SB(0, 1), b2 + hstep, voffB); PG8_STAGE(PG8_SA(0, 0), a2, voffA);
            PG8_WAIT_V(8); PG8_WAIT_L(0); PG8_BAR; PG8_MMA(1, 0, At, B0); PG8_MMA(1, 1, At, B1); PG8_BAR; PG8_SCHED;
            PG8_LDB(B0, 1, 0); PG8_LDB(B1, 1, 1); PG8_SCHED; PG8_LDA(At, 1, 0); PG8_STAGE(PG8_SA(0, 1), a2 + hstep, voffA);
            PG8_WAIT_V(8); PG8_WAIT_L(0); PG8_BAR; PG8_MMA(0, 0, At, B0); PG8_MMA(0, 1, At, B1); PG8_BAR; PG8_SCHED;
            PG8_LDA(At, 1, 1); PG8_STAGE(PG8_SB(1, 0), b3, voffB); PG8_STAGE(PG8_SB(1, 1), b3 + hstep, voffB); PG8_STAGE(PG8_SA(1, 0), a3, voffA);
            PG8_WAIT_V(8); PG8_WAIT_L(0); PG8_BAR; PG8_MMA(1, 0, At, B0); PG8_MMA(1, 1, At, B1); PG8_BAR; PG8_SCHED;
            } else {
            PG8_LDB(B0, 0, 0); PG8_SCHED; PG8_LDA(At, 0, 0); PG8_STAGE(PG8_SA(1, 1), a1 + hstep, voffA);
            PG8_WAIT_L(8); PG8_BAR; PG8_WAIT_L(0); PG8_MMA(0, 0, At, B0); PG8_BAR; PG8_SCHED;
            PG8_LDB(B1, 0, 1); PG8_STAGE(PG8_SB(0, 0), b2, voffB);
            PG8_BAR; PG8_WAIT_L(0); PG8_MMA(0, 1, At, B1); PG8_BAR;
            PG8_LDA(At, 0, 1); PG8_STAGE(PG8_SA(0, 0), a2, voffA);
            PG8_BAR; PG8_WAIT_L(0); PG8_MMA(1, 0, At, B0); PG8_BAR; PG8_SCHED;
            PG8_STAGE(PG8_SB(0, 1), b2 + hstep, voffB);
            PG8_WAIT_V(6); PG8_BAR; PG8_MMA(1, 1, At, B1); PG8_BAR;
            PG8_LDB(B0, 1, 0); PG8_SCHED; PG8_LDA(At, 1, 0); PG8_STAGE(PG8_SA(0, 1), a2 + hstep, voffA);
            PG8_WAIT_L(8); PG8_BAR; PG8_WAIT_L(0); PG8_MMA(0, 0, At, B0); PG8_BAR; PG8_SCHED;
            PG8_LDB(B1, 1, 1); PG8_STAGE(PG8_SB(1, 0), b3, voffB);
            PG8_BAR; PG8_WAIT_L(0); PG8_MMA(0, 1, At, B1); PG8_BAR;
            PG8_LDA(At, 1, 1); PG8_STAGE(PG8_SA(1, 0), a3, voffA);
            PG8_BAR; PG8_WAIT_L(0); PG8_MMA(1, 0, At, B0); PG8_BAR; PG8_SCHED;
            PG8_STAGE(PG8_SB(1, 1), b3 + hstep, voffB);
            PG8_WAIT_V(6); PG8_BAR; PG8_MMA(1, 1, At, B1); PG8_BAR;
            }
        }
        if constexpr (ALIGN_EPI) { if (wr == 0) PG8_BAR; }
        if constexpr (!Epi::AFTER_DRAIN) { E(acc, cur, wr, wc, fr, fq); S.done(cur); }
        if (!has_next) break;
#pragma unroll
        for (int a = 0; a < 2; ++a)
#pragma unroll
            for (int b = 0; b < 2; ++b)
#pragma unroll
                for (int m = 0; m < 4; ++m)
#pragma unroll
                    for (int n = 0; n < 2; ++n) acc[a][b][m][n] = (f32x4){0.f, 0.f, 0.f, 0.f};
        cur = nxt; cA = nA; cB = nB; ++ui;
        if constexpr (ALIGN_EPI) { if (wr == 1) PG8_BAR; }
    }
    PG8_WAIT_V(0);
    if constexpr (!ALIGN_EPI) { if (wr == 0) PG8_BAR; }
    PG8_BAR;
    if constexpr (Epi::AFTER_DRAIN) { E.fused(acc, cur, wr, wc, fr, fq, lds, wid, lane); S.done(cur); }
#undef PG8_SA
#undef PG8_SB
#undef PG8_STAGE
#undef PG8_LDA
#undef PG8_LDB
#undef PG8_MMA
#undef PG8_WAIT_V
#undef PG8_WAIT_L
#undef PG8_BAR
#undef PG8_SCHED
}
}

constexpr int BATCH = 16, SEQ = 2048, DM = 1024, MTOK = BATCH * SEQ, NQKV = 1536, FF = 2816, NH = 16, NKV = 4, HD = 64;
constexpr float RMS_EPS = 1e-6f, LOG2E = 1.4426950408889634f;
constexpr int NWAVES = 8;
#define LAS __attribute__((address_space(3)))
typedef unsigned short bf16;
typedef float f32x4 __attribute__((ext_vector_type(4)));
typedef float f32x16 __attribute__((ext_vector_type(16)));
typedef unsigned u32x4 __attribute__((ext_vector_type(4)));
typedef unsigned u32x2 __attribute__((ext_vector_type(2)));
typedef short bf16x8 __attribute__((ext_vector_type(8)));

constexpr size_t MiB = 1u << 20;
constexpr size_t WS_WQKV = 0, WS_WO = 3 * MiB, WS_WIN = 5 * MiB, WS_WOUT = 11 * MiB, WS_WGU = 13 * MiB  , WS_WD = 35 * MiB  ;
constexpr size_t WS_ROPE = 46 * MiB;
constexpr size_t WS_CTL = 46 * MiB + 768 * 1024;
constexpr size_t WS_RS = 46 * MiB + 832 * 1024;
constexpr size_t WS_XNB = 47 * MiB;
constexpr size_t WS_GH = 48 * MiB;
constexpr size_t WS_XN = 52 * MiB;
constexpr size_t WS_Y = 116 * MiB;
constexpr size_t WS_ACT = 180 * MiB;
constexpr size_t WS_Q = 180 * MiB, WS_K = 244 * MiB, WS_VT = 260 * MiB;
constexpr size_t WS_P = 180 * MiB, WS_Y2 = 244 * MiB;
constexpr size_t WS_END = 356 * MiB;

constexpr int LDS_BYTES = 147456, LDS_BARST = 131072 + 64, LDS_XCH = 131072 + 1024;
constexpr int BAR_WORDS = 3456;

__device__ __forceinline__ unsigned f2bf(float f) { unsigned u = __builtin_bit_cast(unsigned, f); return (u + 0x7fffu + ((u >> 16) & 1u)) >> 16; }
__device__ __forceinline__ unsigned pk2(float lo, float hi) { return f2bf(lo) | (f2bf(hi) << 16); }
__device__ __forceinline__ float wave_sum(float v) {
#pragma unroll
    for (int o = 1; o < 64; o <<= 1) v += __shfl_xor(v, o);
    return v;
}

#define RLX_AGENT __ATOMIC_RELAXED, __HIP_MEMORY_SCOPE_AGENT
#define XB_TMO      128
#define XB_XCNT(j)  (256  + 64 * (j))
#define XB_XSUB(j)  (1280 + 64 * (j))
#define XB_XGEN(j)  (2304 + 64 * (j))
#define XB_TOP      3328
#define XB_TOPGEN   3392
#define XCD_BAR_WORDS 3456
#define XB_SPIN_CAP (1u << 18)

__device__ __forceinline__ unsigned xb_ld(unsigned* p)              { return __hip_atomic_load(p, __ATOMIC_RELAXED, __HIP_MEMORY_SCOPE_AGENT); }
__device__ __forceinline__ unsigned xb_add(unsigned* p, unsigned v) { return __hip_atomic_fetch_add(p, v, __ATOMIC_RELAXED, __HIP_MEMORY_SCOPE_AGENT); }
__device__ __forceinline__ unsigned xb_xcc_id() { return (unsigned)__builtin_amdgcn_s_getreg((3 << 11) | 20) & 0xFu; }
#define XB_SPIN(cond, bar) do { unsigned _sp = 0; while (cond) { __builtin_amdgcn_s_sleep(1); \
    if ((++_sp & 255u) == 0u) { if (xb_ld(&(bar)[XB_TMO])) break; if (_sp > XB_SPIN_CAP) { atomicAdd(&(bar)[XB_TMO], 1u); break; } } } } while (0)

struct XcdBarrier {
    unsigned* bar; unsigned x;
    volatile LAS unsigned* st;
};

__device__ __forceinline__ XcdBarrier xcd_barrier_post(unsigned* bar, volatile LAS unsigned* st) {
    XcdBarrier b; b.bar = bar; b.x = xb_xcc_id(); b.st = st;
    if (threadIdx.x == 0) (void)xb_add(&bar[XB_XCNT(b.x)], 1u);
    return b;
}
__device__ __forceinline__ void xcd_barrier_complete(unsigned* bar, unsigned x, unsigned& nloc, unsigned& nx) {
    const unsigned G = gridDim.x * gridDim.y * gridDim.z;
    unsigned sum, cnt, mine, sp = 0u;
    for (;;) {
        sum = 0u; cnt = 0u; mine = 0u;
#pragma unroll
        for (unsigned j = 0; j < 16; ++j) { const unsigned c = xb_ld(&bar[XB_XCNT(j)]); sum += c; cnt += (c > 0u) ? 1u : 0u; mine = (j == x) ? c : mine; }
        if (sum == G) break;
        __builtin_amdgcn_s_sleep(1);
        if ((++sp & 255u) == 0u) { if (xb_ld(&bar[XB_TMO])) break; if (sp > XB_SPIN_CAP) { atomicAdd(&bar[XB_TMO], 1u); break; } }
    }
    nloc = mine > 0u ? mine : 1u; nx = cnt > 0u ? cnt : 1u;
}

__device__ __forceinline__ void xcd_barrier(const XcdBarrier& b) {
    asm volatile("s_waitcnt vmcnt(0)" ::: "memory");
    __syncthreads();
    if (threadIdx.x == 0) {
        unsigned* bar = b.bar;
        __builtin_amdgcn_s_waitcnt(0);
        unsigned nloc = b.st[0], nx = b.st[1];
        if (nloc == 0u) { xcd_barrier_complete(bar, b.x, nloc, nx); b.st[0] = nloc; b.st[1] = nx; }
        const unsigned old = xb_add(&bar[XB_XSUB(b.x)], 1u);
        const unsigned gen = old / nloc;
        if (old + 1u == (gen + 1u) * nloc) {
            __builtin_amdgcn_fence(__ATOMIC_RELEASE, "agent");
            asm volatile("s_waitcnt vmcnt(0)" ::: "memory");
            const unsigned og = xb_add(&bar[XB_TOP], 1u);
            const unsigned tg = og / nx;
            if (og + 1u == (tg + 1u) * nx) xb_add(&bar[XB_TOPGEN], 1u);
            else XB_SPIN(xb_ld(&bar[XB_TOPGEN]) == tg, bar);
            __builtin_amdgcn_fence(__ATOMIC_ACQUIRE, "agent");
            xb_add(&bar[XB_XGEN(b.x)], 1u);
            asm volatile("s_waitcnt vmcnt(0)" ::: "memory");
        } else {
            XB_SPIN(xb_ld(&bar[XB_XGEN(b.x)]) == gen, bar);
            __builtin_amdgcn_fence(__ATOMIC_ACQUIRE, "agent");
            asm volatile("s_waitcnt vmcnt(0)" ::: "memory");
        }
    }
    __syncthreads();
}

namespace att {
constexpr int KSTR = 144, VSTR = 776, LDS_K = 0, LDS_V = 384 * KSTR;
__device__ __forceinline__ int crow(int r, int hi) { return (r & 3) + 8 * (r >> 2) + 4 * hi; }
#define MFMA32(a, b, c) __builtin_amdgcn_mfma_f32_32x32x16_bf16((a), (b), (c), 0, 0, 0)
__device__ __forceinline__ void attn_phase(LAS unsigned char* lds, bf16* Q, const bf16* Kg, const bf16* Vt, const float* sink) {
    int tid_ = threadIdx.x; asm volatile("" : "+v"(tid_));
    const int tid = tid_, lane = tid & 63, wid = __builtin_amdgcn_readfirstlane(tid >> 6), i32 = lane & 31, hi = lane >> 5;
    for (int u = blockIdx.x; u < BATCH * 16 * NKV; u += gridDim.x) {
        const int kvh = u & 3, blk = (u >> 2) & 15, b = u >> 6;
        const int tlo = blk == 0 ? 128 : 0, thi = blk == 15 ? 256 : 384;
        const long tok0 = (long)b * SEQ + blk * 128 - 128;
#pragma unroll
        for (int j = 0; j < 6; ++j) { const int id = tid + 512 * j, t = id >> 3, c = id & 7;
            if (t >= tlo && t < thi) { const u32x4 v = *(const u32x4*)(Kg + (tok0 + t) * 256 + kvh * 64 + c * 8); *(LAS u32x4*)(lds + LDS_K + t * KSTR + c * 16) = v; } }
#pragma unroll
        for (int j = 0; j < 6; ++j) { const int id = tid + 512 * j, d = id / 48, ch = id % 48, t = ch * 8;
            if (t >= tlo && t < thi) { const u32x4 v = *(const u32x4*)(Vt + (size_t)(kvh * 64 + d) * MTOK + tok0 + t);
                LAS u32x2* p = (LAS u32x2*)(lds + LDS_V + d * VSTR + ch * 16); p[0] = (u32x2){v.x, v.y}; p[1] = (u32x2){v.z, v.w}; } }
        __syncthreads();
        const int g = wid >> 1, r0 = (wid & 1) * 64, h = kvh * 4 + g;
        const long qrow0 = (long)b * SEQ + blk * 128 + r0;
        bf16x8 qf[2][4];
#pragma unroll
        for (int qt = 0; qt < 2; ++qt)
#pragma unroll
            for (int dc = 0; dc < 4; ++dc) qf[qt][dc] = *(const bf16x8*)(Q + (qrow0 + qt * 32 + i32) * 1024 + h * 64 + dc * 16 + hi * 8);
        f32x16 o[2][2];
#pragma unroll
        for (int a = 0; a < 2; ++a)
#pragma unroll
            for (int c = 0; c < 2; ++c)
#pragma unroll
                for (int r = 0; r < 16; ++r) o[a][c][r] = 0.f;
        const float sink2 = sink[h] * LOG2E;
        float mrun[2] = {sink2, sink2}, lrun[2] = {0.f, 0.f};
        const int ktlo = (tlo > r0 ? tlo : r0) >> 5, kthi = (thi < r0 + 320 ? thi : r0 + 320) >> 5;
        for (int kt = ktlo; kt < kthi; ++kt) {
            const int t0 = kt * 32;
            f32x16 s[2];
#pragma unroll
            for (int r = 0; r < 16; ++r) { s[0][r] = 0.f; s[1][r] = 0.f; }
#pragma unroll
            for (int dc = 0; dc < 4; ++dc) { const bf16x8 kf = *(const LAS bf16x8*)(lds + LDS_K + (t0 + i32) * KSTR + dc * 32 + hi * 16);
                s[0] = MFMA32(kf, qf[0][dc], s[0]); s[1] = MFMA32(kf, qf[1][dc], s[1]); }
            bf16x8 vf[2][2];
#pragma unroll
            for (int dt = 0; dt < 2; ++dt)
#pragma unroll
                for (int c = 0; c < 2; ++c) { const LAS unsigned char* vp = lds + LDS_V + (dt * 32 + i32) * VSTR + (t0 + 16 * c + 4 * hi) * 2;
                    const u32x2 lo = *(const LAS u32x2*)vp, hh = *(const LAS u32x2*)(vp + 16); vf[dt][c] = __builtin_bit_cast(bf16x8, (u32x4){lo.x, lo.y, hh.x, hh.y}); }
            const bool full = (t0 >= r0 + 63) && (t0 + 31 <= r0 + 256);
            if (!full) {
#pragma unroll
                for (int qt = 0; qt < 2; ++qt) { const int rq = r0 + qt * 32 + i32;
#pragma unroll
                    for (int r = 0; r < 16; ++r) { const int t = t0 + crow(r, hi); if (t < rq || t > rq + 256) s[qt][r] = -1e30f; } }
            }
#pragma unroll
            for (int qt = 0; qt < 2; ++qt) {
                float mx = s[qt][0];
#pragma unroll
                for (int r = 1; r < 16; ++r) mx = fmaxf(mx, s[qt][r]);
                mx = fmaxf(mx, __shfl_xor(mx, 32));
                const float mn = fmaxf(mrun[qt], mx), alpha = __builtin_amdgcn_exp2f(mrun[qt] - mn);
                mrun[qt] = mn; float ls = 0.f;
#pragma unroll
                for (int r = 0; r < 16; ++r) { const float p = __builtin_amdgcn_exp2f(s[qt][r] - mn); s[qt][r] = p; ls += p; }
                lrun[qt] = lrun[qt] * alpha + ls;
#pragma unroll
                for (int r = 0; r < 16; ++r) { o[qt][0][r] *= alpha; o[qt][1][r] *= alpha; }
                u32x4 p0, p1;
                p0.x = pg8::cvt_pk_bf16(s[qt][0], s[qt][1]); p0.y = pg8::cvt_pk_bf16(s[qt][2], s[qt][3]); p0.z = pg8::cvt_pk_bf16(s[qt][4], s[qt][5]); p0.w = pg8::cvt_pk_bf16(s[qt][6], s[qt][7]);
                p1.x = pg8::cvt_pk_bf16(s[qt][8], s[qt][9]); p1.y = pg8::cvt_pk_bf16(s[qt][10], s[qt][11]); p1.z = pg8::cvt_pk_bf16(s[qt][12], s[qt][13]); p1.w = pg8::cvt_pk_bf16(s[qt][14], s[qt][15]);
                const bf16x8 pf0 = __builtin_bit_cast(bf16x8, p0), pf1 = __builtin_bit_cast(bf16x8, p1);
#pragma unroll
                for (int dt = 0; dt < 2; ++dt) { o[qt][dt] = MFMA32(vf[dt][0], pf0, o[qt][dt]); o[qt][dt] = MFMA32(vf[dt][1], pf1, o[qt][dt]); }
            }
        }
#pragma unroll
        for (int qt = 0; qt < 2; ++qt) {
            const float lt = lrun[qt] + __shfl_xor(lrun[qt], 32) + __builtin_amdgcn_exp2f(sink2 - mrun[qt]);
            const float inv = 1.0f / lt;
            bf16* orow = Q + (qrow0 + qt * 32 + i32) * 1024 + h * 64 + 4 * hi;
#pragma unroll
            for (int dt = 0; dt < 2; ++dt)
#pragma unroll
                for (int r4 = 0; r4 < 4; ++r4) { u32x2 w; w.x = pg8::cvt_pk_bf16(o[qt][dt][4 * r4] * inv, o[qt][dt][4 * r4 + 1] * inv); w.y = pg8::cvt_pk_bf16(o[qt][dt][4 * r4 + 2] * inv, o[qt][dt][4 * r4 + 3] * inv);
                    *(u32x2*)(orow + dt * 32 + 8 * r4) = w; }
        }
        __syncthreads();
    }
}
}

template <bool FIRST, bool LAST>
__device__ __forceinline__ void seam_pass(const float* xin, bf16* hb, const bf16* y, const float* gpost, float* outp, float* rs, bf16* xnb) {
    int tid_ = threadIdx.x; asm volatile("" : "+v"(tid_)); const int lane = tid_ & 63, wave = __builtin_amdgcn_readfirstlane(tid_ >> 6);
    const int gw = blockIdx.x * NWAVES + wave, NGW = gridDim.x * NWAVES;
    f32x4 g[4];
#pragma unroll
    for (int j = 0; j < 4; ++j) g[j] = *(const f32x4*)(gpost + 4 * lane + 256 * j);
    for (int row0 = 2 * gw; row0 < MTOK; row0 += 2 * NGW) {
        f32x4 yv[2][4], hv[2][4];
#pragma unroll
        for (int q = 0; q < 2; ++q) { const size_t off = (size_t)(row0 + q) * DM + 4 * lane;
#pragma unroll
            for (int j = 0; j < 4; ++j) { const u32x2 w = *(const u32x2*)(y + off + 256 * j);
                yv[q][j] = (f32x4){__uint_as_float(w.x << 16), __uint_as_float(w.x & 0xffff0000u), __uint_as_float(w.y << 16), __uint_as_float(w.y & 0xffff0000u)};
                if (FIRST) hv[q][j] = *(const f32x4*)(xin + off + 256 * j);
                else { const u32x2 hw = *(const u32x2*)(hb + off + 256 * j);
                    hv[q][j] = (f32x4){__uint_as_float(hw.x << 16), __uint_as_float(hw.x & 0xffff0000u), __uint_as_float(hw.y << 16), __uint_as_float(hw.y & 0xffff0000u)}; } } }
#pragma unroll
        for (int q = 0; q < 2; ++q) { const int row = row0 + q; const size_t off = (size_t)row * DM + 4 * lane;
            float ss = 0.f;
#pragma unroll
            for (int j = 0; j < 4; ++j) ss += (yv[q][j][0] * yv[q][j][0] + yv[q][j][1] * yv[q][j][1]) + (yv[q][j][2] * yv[q][j][2] + yv[q][j][3] * yv[q][j][3]);
            const float a = 1.0f / sqrtf(wave_sum(ss) * (1.0f / DM) + RMS_EPS);
            float s2 = 0.f;
#pragma unroll
            for (int j = 0; j < 4; ++j) { const f32x4 hn = hv[q][j] + (yv[q][j] * a) * g[j];
                if (LAST) *(f32x4*)(outp + off + 256 * j) = hn;
                else { u32x2 w; w.x = pk2(hn[0], hn[1]); w.y = pk2(hn[2], hn[3]); *(u32x2*)(hb + off + 256 * j) = w;
                    s2 += (hn[0] * hn[0] + hn[1] * hn[1]) + (hn[2] * hn[2] + hn[3] * hn[3]);
                    const int rl = row & 255;
                    if (rl == 255 && row + 1 < MTOK) *(u32x2*)(xnb + (size_t)(2 * ((row + 1) >> 8)) * DM + 4 * lane + 256 * j) = w;
                    if (rl == 0) *(u32x2*)(xnb + (size_t)(2 * (row >> 8) + 1) * DM + 4 * lane + 256 * j) = w; } }
            if (!LAST) { const float r2 = 1.0f / sqrtf(wave_sum(s2) * (1.0f / DM) + RMS_EPS); if (lane == 0) rs[row] = r2; }
        }
    }
}
__device__ __forceinline__ void cast_rows(const float* x, bf16* hb, float* rs) {
    int tid_ = threadIdx.x; asm volatile("" : "+v"(tid_)); const int lane = tid_ & 63, wave = __builtin_amdgcn_readfirstlane(tid_ >> 6);
    const int gw = blockIdx.x * NWAVES + wave, NGW = gridDim.x * NWAVES;
    for (int row0 = 2 * gw; row0 < MTOK; row0 += 2 * NGW) {
        f32x4 v[2][4];
#pragma unroll
        for (int q = 0; q < 2; ++q)
#pragma unroll
            for (int j = 0; j < 4; ++j) v[q][j] = *(const f32x4*)(x + (size_t)(row0 + q) * DM + 4 * lane + 256 * j);
#pragma unroll
        for (int q = 0; q < 2; ++q) { const size_t off = (size_t)(row0 + q) * DM + 4 * lane; float ss = 0.f;
#pragma unroll
            for (int j = 0; j < 4; ++j) { ss += (v[q][j][0] * v[q][j][0] + v[q][j][1] * v[q][j][1]) + (v[q][j][2] * v[q][j][2] + v[q][j][3] * v[q][j][3]);
                u32x2 w; w.x = pk2(v[q][j][0], v[q][j][1]); w.y = pk2(v[q][j][2], v[q][j][3]); *(u32x2*)(hb + off + 256 * j) = w; }
            const float r = 1.0f / sqrtf(wave_sum(ss) * (1.0f / DM) + RMS_EPS); if (lane == 0) rs[row0 + q] = r; }
    }
}

__device__ __forceinline__ int map_col(int mode, int n) {
    if (mode == 1) {
        if (n >= 1280) return n;
        const int p = n & 63, j = p >> 3, e = p & 7; return (n & ~63) + (e < 4 ? 4 * j + e : 32 + 4 * j + (e - 4));
    }
    if (mode == 2) {
        if (n >= 2048) return n - 2048;
        const int j = n >> 8, hsel = (n >> 7) & 1, i = n & 127; return 1024 + hsel * 1024 + 128 * j + i;
    }
    if (mode == 3) { const int j = n >> 8, hsel = (n >> 7) & 1, i = n & 127; return hsel * FF + 128 * j + i; }
    return n;
}
__device__ __forceinline__ void transpose_item(const float* W, int K, int N, bf16* WT, int mode, const float* gain, LAS float* scr, int item, int lane) {
    const int nblk = N / 32, kb = item / nblk, nb = item % nblk, k0 = 64 * kb, n0 = 32 * nb;
    const int src = map_col(mode, n0 + (lane & 31));
#pragma unroll 8
    for (int i = 0; i < 32; ++i) { const int kk = 2 * i + (lane >> 5); scr[kk * 33 + (lane & 31)] = W[(size_t)(k0 + kk) * N + src] * (gain ? gain[k0 + kk] : 1.0f); }
    asm volatile("s_waitcnt lgkmcnt(0)" ::: "memory");
    const int c = lane & 7;
#pragma unroll
    for (int j = 0; j < 4; ++j) { const int n = (lane >> 3) + 8 * j; const LAS float* s = scr + (8 * c) * 33 + n;
        u32x4 o; o.x = pk2(s[0 * 33], s[1 * 33]); o.y = pk2(s[2 * 33], s[3 * 33]); o.z = pk2(s[4 * 33], s[5 * 33]); o.w = pk2(s[6 * 33], s[7 * 33]);
        *(u32x4*)(WT + (size_t)(n0 + n) * K + k0 + 8 * c) = o; }
    asm volatile("s_waitcnt lgkmcnt(0)" ::: "memory");
}
__device__ const float INV_FREQ[32] = {1.000000000e+00f, 7.498942614e-01f, 5.623413324e-01f, 4.216965139e-01f, 3.162277639e-01f, 2.371373773e-01f, 1.778279394e-01f, 1.333521307e-01f, 1.000000015e-01f, 7.498941571e-02f, 5.623413250e-02f, 4.216965288e-02f, 3.162277490e-02f, 2.371373773e-02f, 1.778279431e-02f, 1.333521493e-02f, 9.999999776e-03f, 7.498941850e-03f, 5.623413250e-03f, 4.216964822e-03f, 3.162277630e-03f, 2.371373586e-03f, 1.778279431e-03f, 1.333521446e-03f, 1.000000047e-03f, 7.498942432e-04f, 5.623413017e-04f, 4.216965172e-04f, 3.162277571e-04f, 2.371373703e-04f, 1.778279402e-04f, 1.333521504e-04f};
__device__ __forceinline__ void sincos_f64(float angf, float& c, float& s) {
    const double a = (double)angf, k = __builtin_rint(a * 0.63661977236758134308);
    double r = __builtin_fma(-k, 1.57079632679489655800e+00, a); r = __builtin_fma(-k, 6.12323399573676603587e-17, r);
    const double r2 = r * r;
    double sp = -1.0 / 1307674368000.0; sp = sp * r2 + 1.0 / 6227020800.0; sp = sp * r2 - 1.0 / 39916800.0; sp = sp * r2 + 1.0 / 362880.0; sp = sp * r2 - 1.0 / 5040.0; sp = sp * r2 + 1.0 / 120.0; sp = sp * r2 - 1.0 / 6.0; sp = sp * r2 + 1.0;
    double cp = 1.0 / 20922789888000.0; cp = cp * r2 - 1.0 / 87178291200.0; cp = cp * r2 + 1.0 / 479001600.0; cp = cp * r2 - 1.0 / 3628800.0; cp = cp * r2 + 1.0 / 40320.0; cp = cp * r2 - 1.0 / 720.0; cp = cp * r2 + 1.0 / 24.0; cp = cp * r2 - 0.5; cp = cp * r2 + 1.0;
    const double sr = sp * r, cr = cp; const int q = (int)((long long)k & 3);
    const double cc = (q == 0) ? cr : (q == 1) ? -sr : (q == 2) ? -cr : sr;
    const double sv = (q == 0) ? sr : (q == 1) ? cr : (q == 2) ? -sr : -cr;
    c = (float)cc; s = (float)sv;
}

#ifndef PHASES
#define PHASES 0xffff
#endif
#define PH(k) ((PHASES >> (k)) & 1)
#ifndef DUP_MASK
#define DUP_MASK 0
#endif
#define REP(k) for (int rep_ = 0; rep_ < 1 + ((DUP_MASK >> (k)) & 1); ++rep_)
struct Args { const float* in[12]; float* out; unsigned char* ws; };

typedef const Args __attribute__((address_space(4)))* ArgsP;
#define PTRS ArgsP ap_ = (ArgsP)__builtin_amdgcn_kernarg_segment_ptr(); asm volatile("" : "+s"(ap_)); \
    unsigned char* ws = ap_->ws; (void)ws; \
    const float* x = ap_->in[0]; const int* positions = (const int*)ap_->in[1]; const float* w_qkv = ap_->in[2]; const float* sink = ap_->in[3]; const float* w_o = ap_->in[4]; \
    const float* w_in = ap_->in[5]; const float* conv_w = ap_->in[6]; const float* w_out = ap_->in[7]; const float* gains = ap_->in[8]; const float* w_gu = ap_->in[9]; \
    const float* ffn_cw = ap_->in[10]; const float* w_dn = ap_->in[11]; float* out = ap_->out; \
    bf16* Wqkv_t = (bf16*)(ws + WS_WQKV); bf16* Wo_t = (bf16*)(ws + WS_WO); bf16* Win_t = (bf16*)(ws + WS_WIN); bf16* Wout_t = (bf16*)(ws + WS_WOUT); \
    bf16* Wgu_t = (bf16*)(ws + WS_WGU); bf16* Wd_t = (bf16*)(ws + WS_WD); float* rcos = (float*)(ws + WS_ROPE); float* rsin = rcos + SEQ * 32; \
    float* RS = (float*)(ws + WS_RS); (void)RS; bf16* XN = (bf16*)(ws + WS_XN); bf16* XNB = (bf16*)(ws + WS_XNB); bf16* GH = (bf16*)(ws + WS_GH); (void)XNB; (void)GH; bf16* Y = (bf16*)(ws + WS_Y); bf16* ACT = (bf16*)(ws + WS_ACT); \
    bf16* QB = (bf16*)(ws + WS_Q); bf16* KB = (bf16*)(ws + WS_K); bf16* VT = (bf16*)(ws + WS_VT); bf16* PB = (bf16*)(ws + WS_P); bf16* Y2 = (bf16*)(ws + WS_Y2); \
    (void)x; (void)positions; (void)w_qkv; (void)sink; (void)w_o; (void)w_in; (void)conv_w; (void)w_out; (void)gains; (void)w_gu; (void)ffn_cw; (void)w_dn; (void)out; \
    (void)Wqkv_t; (void)Wo_t; (void)Win_t; (void)Wout_t; (void)Wgu_t; (void)Wd_t; (void)rcos; (void)rsin; (void)XN; (void)Y; (void)ACT; (void)QB; (void)KB; (void)VT; (void)PB; (void)Y2; \
    const int G = gridDim.x; (void)G

__global__ void __launch_bounds__(NWAVES * 64, 2) fwd_megakernel(Args args) {
    extern __shared__ __attribute__((aligned(16))) unsigned char lds_raw[];
    LAS unsigned char* lds = (LAS unsigned char*)lds_raw;
    cg::grid_group grid = cg::this_grid();
#define SYNC() do { ArgsP bp_ = (ArgsP)__builtin_amdgcn_kernarg_segment_ptr(); XcdBarrier b_; b_.bar = (unsigned*)(bp_->ws + WS_CTL); b_.x = xb_xcc_id(); b_.st = (volatile LAS unsigned*)(lds + LDS_BARST); xcd_barrier(b_); } while (0)
    if (threadIdx.x == 0) { ((volatile LAS unsigned*)(lds + LDS_BARST))[0] = 0u; ((volatile LAS unsigned*)(lds + LDS_BARST))[1] = 0u; }
    if (blockIdx.x == 0) { unsigned* ctl = (unsigned*)(args.ws + WS_CTL); for (int i = threadIdx.x; i < BAR_WORDS; i += NWAVES * 64) ctl[i] = 0u; }
    __syncthreads();

    REP(0) if (PH(0)) {
        PTRS;
        int tid_ = threadIdx.x; asm volatile("" : "+v"(tid_)); const int tid = tid_, lane = tid & 63, wave = __builtin_amdgcn_readfirstlane(tid >> 6);
        LAS float* scr = (LAS float*)(lds + wave * 16384);
        const int gw = blockIdx.x * NWAVES + wave, NGW = G * NWAVES;
        constexpr int I_QKV = 16 * (NQKV / 32), I_O = 16 * 32, I_IN = 16 * 96, I_OUT = 16 * 32, I_GU = 16 * (2 * FF / 32), I_D = (FF / 64) * 32;
        constexpr int NITEMS = I_QKV + I_O + I_IN + I_OUT + 2 * I_GU + 2 * I_D;
        for (int it = gw; it < NITEMS; it += NGW) {
            int r = it;
            if (r < I_QKV) { transpose_item(w_qkv, DM, NQKV, Wqkv_t, 1, gains, scr, r, lane); continue; } r -= I_QKV;
            if (r < I_O) { transpose_item(w_o, DM, DM, Wo_t, 0, nullptr, scr, r, lane); continue; } r -= I_O;
            if (r < I_IN) { transpose_item(w_in, DM, 3 * DM, Win_t, 2, gains + 4 * DM, scr, r, lane); continue; } r -= I_IN;
            if (r < I_OUT) { transpose_item(w_out, DM, DM, Wout_t, 0, nullptr, scr, r, lane); continue; } r -= I_OUT;
            if (r < I_GU) { transpose_item(w_gu, DM, 2 * FF, Wgu_t, 3, gains + 2 * DM, scr, r, lane); continue; } r -= I_GU;
            if (r < I_GU) { transpose_item(w_gu + (size_t)DM * 2 * FF, DM, 2 * FF, Wgu_t + (size_t)2 * FF * DM, 3, gains + 6 * DM, scr, r, lane); continue; } r -= I_GU;
            if (r < I_D) { transpose_item(w_dn, FF, DM, Wd_t, 0, nullptr, scr, r, lane); continue; } r -= I_D;
            transpose_item(w_dn + (size_t)FF * DM, FF, DM, Wd_t + (size_t)DM * FF, 0, nullptr, scr, r, lane);
        }
        for (int e = blockIdx.x * (NWAVES * 64) + tid; e < SEQ * 32; e += G * NWAVES * 64) {
            const int s = e >> 5, i = e & 31; const float ang = (float)positions[s] * INV_FREQ[i];
            float c, sn; sincos_f64(ang, c, sn); rcos[e] = c; rsin[e] = sn;
        }
        cast_rows(x, XN, RS);
    }
    grid.sync();
    if (threadIdx.x == 0) (void)xb_add(&((unsigned*)(args.ws + WS_CTL))[XB_XCNT(xb_xcc_id())], 1u);
    REP(1) if (PH(1)) {
        PTRS;
        pg8::Gemm g{XN, Wqkv_t, MTOK, 1280, DM, Wqkv_t + (size_t)1280 * DM, XN}; pg8::StaticOrder S; S.init(MTOK, 1280, G, (int)blockIdx.x, MTOK / 256);
        pg8::EpiQKV E{QB, (long)((WS_K - WS_Q) / 2), (long)((WS_VT - WS_Q) / 2), rcos, rsin, RS, 0.125f * LOG2E, MTOK};
        pg8::gemm_phase<pg8::EpiQKV, pg8::StaticOrder, true, true>(lds, g, S, E);
    }
    SYNC();
    if (PH(2)) { PTRS; att::attn_phase(lds, QB, KB, VT, sink); }
    SYNC();
    REP(3) if (PH(3)) {
        PTRS;
        pg8::Gemm g{QB, Wo_t, MTOK, DM, DM, nullptr, nullptr}; pg8::StaticOrder S; S.init(MTOK, DM, G, (int)blockIdx.x);
        pg8::EpiStore E{Y, DM};
        pg8::gemm_phase<pg8::EpiStore, pg8::StaticOrder, true, true>(lds, g, S, E);
    }
    SYNC();
    REP(4) if (PH(4)) { PTRS; seam_pass<true, false>(x, XN, Y, gains + 1 * DM, nullptr, RS, XNB); }
    SYNC();
#pragma unroll 1
    for (int layer = 0; layer < 2; ++layer) {
        if (PH(5) && layer == 1) {
            REP(7) if (PH(7)) {
                PTRS;
                pg8::Gemm g{XN, Win_t, MTOK, 2048, DM, nullptr, nullptr}; pg8::StaticOrder S; S.init(MTOK, 2048, G, (int)blockIdx.x);
                pg8::EpiCX E{PB, RS};
                pg8::gemm_phase<pg8::EpiCX, pg8::StaticOrder, true, true>(lds, g, S, E);
            }
            SYNC();
            REP(8) if (PH(8)) {
                PTRS;
                pg8::Gemm g{XN, Win_t + (size_t)2048 * DM, MTOK, DM, DM, nullptr, nullptr}; pg8::StaticOrder S; S.init(MTOK, DM, G, (int)blockIdx.x);
                pg8::EpiConv<0> E{PB, conv_w, Y2, DM, RS};
                pg8::gemm_phase<pg8::EpiConv<0>, pg8::StaticOrder, true, true>(lds, g, S, E);
            }
            SYNC();
            REP(9) if (PH(9)) {
                PTRS;
                pg8::Gemm g{Y2, Wout_t, MTOK, DM, DM, nullptr, nullptr}; pg8::StaticOrder S; S.init(MTOK, DM, G, (int)blockIdx.x);
                pg8::EpiStore E{Y, DM};
                pg8::gemm_phase<pg8::EpiStore, pg8::StaticOrder, true, true>(lds, g, S, E);
            }
            SYNC();
            { PTRS; seam_pass<false, false>(nullptr, XN, Y, gains + 5 * DM, nullptr, RS, XNB); }
            SYNC();
        }
        if (!PH(6)) continue;
        REP(10) if (PH(10)) {
            PTRS; const bf16* Wg = Wgu_t + (size_t)layer * 2 * FF * DM;
            pg8::Gemm g{XNB, Wg, 256, 2 * FF, DM, nullptr, nullptr}; pg8::StaticOrder S; S.init(256, 2 * FF, G, (int)blockIdx.x);
            pg8::EpiStore E{GH, 2 * FF};
            pg8::gemm_phase<pg8::EpiStore, pg8::StaticOrder, true, true>(lds, g, S, E);
        }
        SYNC();
        REP(11) if (PH(11)) {
            PTRS; const bf16* Wg = Wgu_t + (size_t)layer * 2 * FF * DM;
            pg8::Gemm g{XN, Wg, MTOK, 2 * FF, DM, nullptr, nullptr}; pg8::StaticOrder S; S.init(MTOK, 2 * FF, G, (int)blockIdx.x);
            pg8::EpiGU E{GH, ffn_cw + (size_t)layer * 3 * FF, ACT, lds + LDS_XCH, FF, RS};
            pg8::gemm_phase<pg8::EpiGU, pg8::StaticOrder, true, true>(lds, g, S, E);
        }
        SYNC();
#ifdef PROBE_PLAINUP
        if (layer == 0) {
            PTRS; const bf16* Wg = Wgu_t + (size_t)layer * 2 * FF * DM;
            pg8::Gemm g{XN, Wg, MTOK, 2 * FF, DM, nullptr, nullptr}; pg8::StaticOrder S; S.init(MTOK, 2 * FF, G, (int)blockIdx.x);
            pg8::EpiStore E{(bf16*)(ws + WS_END), DM};
            pg8::gemm_phase<pg8::EpiStore, pg8::StaticOrder, true, true>(lds, g, S, E);
        }
#endif
        REP(12) if (PH(12)) {
            PTRS; const bf16* Wd = Wd_t + (size_t)layer * DM * FF;
            pg8::Gemm g{ACT, Wd, MTOK, DM, FF, nullptr, nullptr}; pg8::StaticOrder S; S.init(MTOK, DM, G, (int)blockIdx.x);
            pg8::EpiStore E{Y, DM};
            pg8::gemm_phase<pg8::EpiStore, pg8::StaticOrder, true, true>(lds, g, S, E);
        }
        SYNC();
        { PTRS; if (layer == 0) seam_pass<false, false>(nullptr, XN, Y, gains + 3 * DM, nullptr, RS, XNB); else seam_pass<false, true>(nullptr, XN, Y, gains + 7 * DM, out, nullptr, nullptr); }
        if (layer == 0) SYNC();
    }
}

extern "C" void kernel_launch(void* const* d_in, const int* in_sizes, int n_in, void* d_out, int out_size, void* d_ws, size_t ws_size, hipStream_t stream) {
    static int grid = 0;
    if (grid == 0) {
        if (n_in != 12 || in_sizes[0] != MTOK * DM || out_size != MTOK * DM || ws_size < WS_END) { fprintf(stderr, "kernel_launch: unexpected shapes / workspace (n_in %d, in0 %d, out %d, ws %zu)\n", n_in, n_in > 0 ? in_sizes[0] : -1, out_size, ws_size); grid = -1; return; }
        int dev = 0, cus = 0, per_cu = 0;
        hipGetDevice(&dev); hipDeviceGetAttribute(&cus, hipDeviceAttributeMultiprocessorCount, dev);
        if (hipFuncSetAttribute((const void*)fwd_megakernel, hipFuncAttributeMaxDynamicSharedMemorySize, LDS_BYTES) != hipSuccess) { fprintf(stderr, "kernel_launch: hipFuncSetAttribute failed\n"); grid = -1; return; }
        if (hipOccupancyMaxActiveBlocksPerMultiprocessor(&per_cu, (const void*)fwd_megakernel, NWAVES * 64, LDS_BYTES) != hipSuccess || per_cu < 1) { fprintf(stderr, "kernel_launch: occupancy query says %d\n", per_cu); per_cu = 1; }
        (void)hipGetLastError();
        grid = cus * per_cu;
    }
    if (grid < 0) return;
    Args a{};
    for (int i = 0; i < 12; ++i) a.in[i] = (const float*)d_in[i];
    a.out = (float*)d_out; a.ws = (unsigned char*)d_ws;
    void* kargs[] = {&a};
    hipError_t e = hipLaunchCooperativeKernel((const void*)fwd_megakernel, dim3(grid), dim3(NWAVES * 64), kargs, LDS_BYTES, stream);
    if (e != hipSuccess) fprintf(stderr, "kernel_launch: cooperative launch failed: %s (grid %d)\n", hipGetErrorString(e), grid);
}
```

```cpp
#include <hip/hip_runtime.h>
#include <hip/hip_cooperative_groups.h>
#include <cstdio>
#include <cstdint>
namespace cg = cooperative_groups;
namespace pg8 {
#define PG8_LAS __attribute__((address_space(3)))
typedef unsigned short bf16_t;
typedef short bf16x8 __attribute__((ext_vector_type(8)));
typedef float f32x4 __attribute__((ext_vector_type(4)));
typedef unsigned u32x4 __attribute__((ext_vector_type(4)));
constexpr int BM = 256, BK = 64, HALF = 128, HTB = HALF * BK * 2  , STAGE_BYTES = 8 * HTB, NXCD = 8, WGM = 8;

__host__ __device__ __forceinline__ int lds_byte(int r, int c) { const int st = (r >> 4) * 2 + (c >> 5), rr = r & 15, cc = c & 31, ob = rr * 64 + cc * 2; return st * 1024 + (ob ^ (((ob >> 9) & 1) << 5)); }
__host__ __device__ __forceinline__ void stage_rc(int b, int& R, int& C) { const int st = b / 1024, sb = b % 1024, swz = sb ^ (((sb >> 9) & 1) << 5); R = (st >> 1) * 16 + swz / 64; C = (st & 1) * 32 + (swz % 64) / 2; }
__host__ __device__ __forceinline__ int perm32(int rho) { const int n = rho >> 4, i = rho & 15; return 8 * (i >> 2) + 4 * n + (i & 3); }

typedef unsigned u32x2 __attribute__((ext_vector_type(2)));
struct Unit { int pm, pn, w; };
struct Gemm { const bf16_t* A; const bf16_t* Bt; int M, N, K; const bf16_t* A2; const bf16_t* Bt2; };

struct StaticOrder {
    int nM, nN, nwg, G, c, n2;
    __host__ __device__ void init(int M, int N, int G_, int c_, int n2_ = 0) { nM = M / BM; nN = N / BM; nwg = nM * nN; G = G_; c = c_; n2 = n2_; }
    __host__ __device__ bool next(int i, Unit& u) const {
        const long L = (long)i * G + c; if (L >= nwg + n2) return false;
        if (L >= nwg) { u.w = 1; u.pm = 0; u.pn = (int)(L - nwg); return true; }
        u.w = 0;
        int wgid = (int)L; { const int q = nwg / NXCD, r = nwg % NXCD, xcd = wgid % NXCD, off = wgid / NXCD; wgid = (xcd < r ? xcd * (q + 1) : r * (q + 1) + (xcd - r) * q) + off; }
        const int nig = WGM * nN, gid = wgid / nig, fm = gid * WGM, gsz = (nM - fm) < WGM ? (nM - fm) : WGM;
        u.pm = fm + ((wgid % nig) % gsz); u.pn = (wgid % nig) / gsz; return true;
    }
    __device__ __forceinline__ void a_ready(const Unit&) const {}
    __device__ __forceinline__ void done(const Unit&) const {}
};

typedef float f32x2_t __attribute__((ext_vector_type(2))); typedef __bf16 bf16x2_t __attribute__((ext_vector_type(2)));
__device__ __forceinline__ unsigned cvt_pk_bf16(float lo, float hi) { const f32x2_t v = {lo, hi}; const bf16x2_t b = __builtin_convertvector(v, bf16x2_t); return __builtin_bit_cast(unsigned, b); }
__device__ __forceinline__ u32x4 pack8(const f32x4 a, const f32x4 b) { u32x4 w; w.x = cvt_pk_bf16(a[0], a[1]); w.y = cvt_pk_bf16(a[2], a[3]); w.z = cvt_pk_bf16(b[0], b[1]); w.w = cvt_pk_bf16(b[2], b[3]); return w; }
__device__ __forceinline__ f32x4 bf_lo4(const u32x4 w) { return (f32x4){__uint_as_float(w.x << 16), __uint_as_float(w.x & 0xffff0000u), __uint_as_float(w.y << 16), __uint_as_float(w.y & 0xffff0000u)}; }
__device__ __forceinline__ f32x4 bf_hi4(const u32x4 w) { return (f32x4){__uint_as_float(w.z << 16), __uint_as_float(w.z & 0xffff0000u), __uint_as_float(w.w << 16), __uint_as_float(w.w & 0xffff0000u)}; }

struct EpiStore {
    static constexpr bool PERM = true, AFTER_DRAIN = false;
    bf16_t* O; int ldc;
    __device__ __forceinline__ void operator()(const f32x4 (&acc)[2][2][4][2], const Unit& u, int wr, int wc, int fr, int fq) const {
        const int row0 = u.pm * BM + wr * 64 + fr, col0 = u.pn * BM + wc * 32 + 8 * fq;
#pragma unroll
        for (int ai = 0; ai < 2; ++ai)
#pragma unroll
            for (int m = 0; m < 4; ++m) { bf16_t* rowp = O + (size_t)(row0 + ai * HALF + m * 16) * ldc + col0;
#pragma unroll
                for (int bj = 0; bj < 2; ++bj) *(u32x4*)(rowp + bj * HALF) = pack8(acc[ai][bj][m][0], acc[ai][bj][m][1]); }
    }
};

struct EpiQKV {
    static constexpr bool PERM = true, AFTER_DRAIN = false;
    bf16_t* Q; long offK, offV; const float* rcos; const float* rsin; const float* rs; float qscale; int mtok;
    __device__ __forceinline__ void operator()(const f32x4 (&acc)[2][2][4][2], const Unit& u, int wr, int wc, int fr, int fq) const {
        const bool isv = u.w != 0, isq = u.pn < 4;
        bf16_t* base = Q + (isv ? offV : (isq ? 0L : offK)); const int ldc = isv ? mtok : (isq ? 1024 : 256), colt = (isv || isq) ? u.pn * BM : 0; const float sc = (!isv && isq) ? qscale : 1.0f;
        const int i0 = 4 * ((wc & 1) * 4 + fq);
#pragma unroll
        for (int ai = 0; ai < 2; ++ai)
#pragma unroll
            for (int m = 0; m < 4; ++m) {
                const int row = u.pm * BM + ai * HALF + wr * 64 + m * 16 + fr, s = row & 2047;
                f32x4 c = (f32x4){1.f, 1.f, 1.f, 1.f}, sn = (f32x4){0.f, 0.f, 0.f, 0.f};
                if (!isv) { const float rr = rs[row] * sc; c = *(const f32x4*)(rcos + s * 32 + i0) * rr; sn = *(const f32x4*)(rsin + s * 32 + i0) * rr; }
                bf16_t* rowp = base + (size_t)row * ldc + colt + wc * 32 + 8 * fq;
#pragma unroll
                for (int bj = 0; bj < 2; ++bj) { f32x4 x1 = acc[ai][bj][m][0], x2 = acc[ai][bj][m][1];
                    if (isv) { const float* rp = rs + u.pn * BM + bj * HALF + wc * 32 + 8 * fq; x1 = x1 * *(const f32x4*)rp; x2 = x2 * *(const f32x4*)(rp + 4); }
                    *(u32x4*)(rowp + bj * HALF) = pack8(x1 * c - x2 * sn, x2 * c + x1 * sn); }
                if (m & 1) asm volatile("" ::: "memory");
            }
    }
};

struct EpiCX {
    static constexpr bool PERM = true, AFTER_DRAIN = false;
    bf16_t* P; const float* rs;
    __device__ __forceinline__ void operator()(const f32x4 (&acc)[2][2][4][2], const Unit& u, int wr, int wc, int fr, int fq) const {
        const int row0 = u.pm * BM + wr * 64 + fr, col0 = u.pn * HALF + wc * 32 + 8 * fq;
#pragma unroll
        for (int ai = 0; ai < 2; ++ai)
#pragma unroll
            for (int m = 0; m < 4; ++m) { const int row = row0 + ai * HALF + m * 16; const float r1 = rs[row], r2 = r1 * r1;
                *(u32x4*)(P + (size_t)row * 1024 + col0) = pack8(acc[ai][0][m][0] * acc[ai][1][m][0] * r2, acc[ai][0][m][1] * acc[ai][1][m][1] * r2); }
    }
};

template <int MODE> struct EpiConv {
    static constexpr bool PERM = true, AFTER_DRAIN = false;
    const bf16_t* G; const float* cw; bf16_t* O; int ldc; const float* rs;
    __device__ __forceinline__ void operator()(const f32x4 (&acc)[2][2][4][2], const Unit& u, int wr, int wc, int fr, int fq) const {
        const int row0 = u.pm * BM + wr * 64 + fr;
#pragma unroll
        for (int bj = 0; bj < 2; ++bj) {
            const int col = u.pn * BM + bj * HALF + wc * 32 + 8 * fq;
            const f32x4 w0a = *(const f32x4*)(cw + col), w0b = *(const f32x4*)(cw + col + 4);
            const f32x4 w1a = *(const f32x4*)(cw + ldc + col), w1b = *(const f32x4*)(cw + ldc + col + 4);
            const f32x4 w2a = *(const f32x4*)(cw + 2 * ldc + col), w2b = *(const f32x4*)(cw + 2 * ldc + col + 4);
#pragma unroll
            for (int ai = 0; ai < 2; ++ai)
#pragma unroll
                for (int m = 0; m < 4; ++m) {
                    const int row = row0 + ai * HALF + m * 16, s = row & 2047; const float rr = rs[row];
                    const bf16_t* gp = G + (size_t)row * ldc + col;
                    const u32x4 zc = *(const u32x4*)gp;
                    u32x4 zp = (u32x4){0u, 0u, 0u, 0u}, zn = (u32x4){0u, 0u, 0u, 0u};
                    if (s > 0) zp = *(const u32x4*)(gp - ldc);
                    if (s < 2047) zn = *(const u32x4*)(gp + ldc);
                    f32x4 za = w0a * bf_lo4(zp) + w1a * bf_lo4(zc) + w2a * bf_lo4(zn);
                    f32x4 zb = w0b * bf_hi4(zp) + w1b * bf_hi4(zc) + w2b * bf_hi4(zn);
                    f32x4 oa, ob;
                    if (MODE == 0) { oa = acc[ai][bj][m][0] * za * rr; ob = acc[ai][bj][m][1] * zb * rr; }
                    else {
#pragma unroll
                        for (int e = 0; e < 4; ++e) {
                            oa[e] = za[e] * __builtin_amdgcn_rcpf(1.0f + __builtin_amdgcn_exp2f(za[e] * -1.4426950408889634f)) * acc[ai][bj][m][0][e];
                            ob[e] = zb[e] * __builtin_amdgcn_rcpf(1.0f + __builtin_amdgcn_exp2f(zb[e] * -1.4426950408889634f)) * acc[ai][bj][m][1][e]; }
                    }
                    *(u32x4*)(O + (size_t)row * ldc + col) = pack8(oa, ob);
                    if (m & 1) asm volatile("" ::: "memory");
                }
        }
    }
};

__device__ __forceinline__ float dpp_shr1(float oldv, float src) { return __int_as_float(__builtin_amdgcn_update_dpp(__float_as_int(oldv), __float_as_int(src), 0x111, 0xf, 0xf, false)); }
__device__ __forceinline__ float dpp_shl1(float oldv, float src) { return __int_as_float(__builtin_amdgcn_update_dpp(__float_as_int(oldv), __float_as_int(src), 0x101, 0xf, 0xf, false)); }
__device__ __forceinline__ float dpp_ror1(float src) { return __int_as_float(__builtin_amdgcn_update_dpp(0, __float_as_int(src), 0x121, 0xf, 0xf, false)); }
__device__ __forceinline__ float dpp_ror15(float src) { return __int_as_float(__builtin_amdgcn_update_dpp(0, __float_as_int(src), 0x12F, 0xf, 0xf, false)); }
struct EpiGU {
    static constexpr bool PERM = true, AFTER_DRAIN = false;
    const bf16_t* GH; const float* cw; bf16_t* ACT; PG8_LAS unsigned char* xlds; int ff; const float* rs;
    __device__ __forceinline__ void operator()(f32x4 (&acc)[2][2][4][2], const Unit& u, int wr, int wc, int fr, int fq) const {
        const int colg = 32 * wc + 8 * fq, ch0 = u.pn * HALF + colg, pmod = u.pm & 7;
        { float rr[2][4];
#pragma unroll
            for (int ai = 0; ai < 2; ++ai)
#pragma unroll
                for (int m = 0; m < 4; ++m) rr[ai][m] = rs[u.pm * BM + ai * HALF + wr * 64 + m * 16 + fr];
#pragma unroll
            for (int ai = 0; ai < 2; ++ai)
#pragma unroll
                for (int m = 0; m < 4; ++m)
#pragma unroll
                    for (int bj = 0; bj < 2; ++bj)
#pragma unroll
                        for (int n = 0; n < 2; ++n) acc[ai][bj][m][n] = acc[ai][bj][m][n] * rr[ai][m]; }
        u32x4 topv = (u32x4){0u, 0u, 0u, 0u}, botv = (u32x4){0u, 0u, 0u, 0u}; float rtop = 0.f, rbot = 0.f;
        if (wr == 0 && fr == 0 && pmod != 0) { topv = *(const u32x4*)(GH + (size_t)(2 * u.pm) * (2 * ff) + u.pn * BM + colg); rtop = rs[u.pm * BM - 1]; }
        if (wr == 1 && fr == 15 && pmod != 7) { botv = *(const u32x4*)(GH + (size_t)(2 * (u.pm + 1) + 1) * (2 * ff) + u.pn * BM + colg); rbot = rs[u.pm * BM + BM]; }
        PG8_LAS float* XF = (PG8_LAS float*)xlds; PG8_LAS float* XL = XF + 4 * HALF;
        if (fr == 0) {
#pragma unroll
            for (int ai = 0; ai < 2; ++ai)
#pragma unroll
                for (int n = 0; n < 2; ++n) *(PG8_LAS f32x4*)(XF + (2 * ai + wr) * HALF + colg + 4 * n) = acc[ai][0][0][n];
        }
        if (fr == 15) {
#pragma unroll
            for (int ai = 0; ai < 2; ++ai)
#pragma unroll
                for (int n = 0; n < 2; ++n) *(PG8_LAS f32x4*)(XL + (2 * ai + wr) * HALF + colg + 4 * n) = acc[ai][0][3][n];
        }
        asm volatile("s_waitcnt lgkmcnt(0)" ::: "memory"); __builtin_amdgcn_s_barrier(); asm volatile("" ::: "memory");
#pragma unroll
        for (int ai = 0; ai < 2; ++ai) {
            const int k = 2 * ai + wr;
            f32x4 pr[2], nx[2];
#pragma unroll
            for (int n = 0; n < 2; ++n) {
                pr[n] = (k == 0) ? (n == 0 ? bf_lo4(topv) : bf_hi4(topv)) * rtop : *(const PG8_LAS f32x4*)(XL + (k - 1) * HALF + colg + 4 * n);
                nx[n] = (k == 3) ? (n == 0 ? bf_lo4(botv) : bf_hi4(botv)) * rbot : *(const PG8_LAS f32x4*)(XF + ((k + 1) & 3) * HALF + colg + 4 * n);
            }
#pragma unroll
            for (int n = 0; n < 2; ++n) {
                const f32x4 w0 = *(const f32x4*)(cw + ch0 + 4 * n), w1 = *(const f32x4*)(cw + ff + ch0 + 4 * n), w2 = *(const f32x4*)(cw + 2 * ff + ch0 + 4 * n);
#pragma unroll
                for (int m = 0; m < 4; ++m) {
                    f32x4 o;
#pragma unroll
                    for (int e = 0; e < 4; ++e) {
                        const float g = acc[ai][0][m][n][e];
                        const float oldp = (m == 0) ? pr[n][e] : dpp_ror1(acc[ai][0][m > 0 ? m - 1 : 0][n][e]);
                        const float oldn = (m == 3) ? nx[n][e] : dpp_ror15(acc[ai][0][m < 3 ? m + 1 : 3][n][e]);
                        const float P = dpp_shr1(oldp, g), N = dpp_shl1(oldn, g);
                        const float z = w0[e] * P + w1[e] * g + w2[e] * N;
                        o[e] = z * __builtin_amdgcn_rcpf(1.0f + __builtin_amdgcn_exp2f(z * -1.4426950408889634f)) * acc[ai][1][m][n][e];
                    }
                    u32x2 w; w.x = cvt_pk_bf16(o[0], o[1]); w.y = cvt_pk_bf16(o[2], o[3]);
                    *(u32x2*)(ACT + (size_t)(u.pm * BM + ai * HALF + wr * 64 + m * 16 + fr) * ff + ch0 + 4 * n) = w;
                }
            }
        }
    }
};

template <class Epi, class Sched, bool ALIGN_EPI = false, bool SP2 = false>
__device__ __forceinline__ void gemm_phase(PG8_LAS unsigned char* lds, const Gemm g, const Sched& S, const Epi& E) {
    int tid_ = threadIdx.x; asm volatile("" : "+v"(tid_));
    const int tid = tid_, wid = __builtin_amdgcn_readfirstlane(tid >> 6), lane = tid & 63, wr = wid >> 2, wc = wid & 3, fr = lane & 15, fq = lane >> 4;
    const int K = g.K, nt = K / BK;
    unsigned voffA[2], voffB[2];
#pragma unroll
    for (int i = 0; i < 2; ++i) { int R, C; stage_rc(tid * 16 + i * 8192, R, C); const int Rb = Epi::PERM ? ((R & ~31) + perm32(R & 31)) : R;
        voffA[i] = (unsigned)(R * K + C) * 2u; voffB[i] = (unsigned)(Rb * K + C) * 2u; }
    const size_t kstep = (size_t)(BK * 2);
    const size_t hstep = (size_t)HALF * K * 2;
    const size_t tstep = 2 * hstep;
    const unsigned ldsw = (unsigned)wid * 1024u;
    const int aoff = lds_byte(wr * 64 + fr, fq * 8), boff = lds_byte(wc * 32 + fr, fq * 8);
#define PG8_SA(b, h) (((b) * 2 + (h)) * HTB)
#define PG8_SB(b, h) ((4 + (b) * 2 + (h)) * HTB)
#define PG8_STAGE(bufoff, gbase, voff) do { _Pragma("unroll") for (int _i = 0; _i < 2; ++_i) \
        __builtin_amdgcn_global_load_lds((const unsigned*)((const char*)(gbase) + (voff)[_i]), (PG8_LAS unsigned*)(lds + (bufoff) + ldsw + _i * 8192), 16, 0, 0); } while (0)
#define PG8_LDA(dst, b, h) do { _Pragma("unroll") for (int m = 0; m < 4; ++m) _Pragma("unroll") for (int k = 0; k < 2; ++k) dst[m][k] = *(const PG8_LAS bf16x8*)(lds + PG8_SA(b, h) + aoff + m * 2048 + k * 1024); } while (0)
#define PG8_LDB(dst, b, h) do { _Pragma("unroll") for (int n = 0; n < 2; ++n) _Pragma("unroll") for (int k = 0; k < 2; ++k) dst[n][k] = *(const PG8_LAS bf16x8*)(lds + PG8_SB(b, h) + boff + n * 2048 + k * 1024); } while (0)
#define PG8_MMA(ai, bj, At, Bt) do { __builtin_amdgcn_s_setprio(1); _Pragma("unroll") for (int m = 0; m < 4; ++m) _Pragma("unroll") for (int n = 0; n < 2; ++n) _Pragma("unroll") for (int k = 0; k < 2; ++k) \
        acc[ai][bj][m][n] = __builtin_amdgcn_mfma_f32_16x16x32_bf16(Bt[n][k], At[m][k], acc[ai][bj][m][n], 0, 0, 0); __builtin_amdgcn_s_setprio(0); } while (0)
#define PG8_WAIT_V(n) asm volatile("s_waitcnt vmcnt(" #n ")" ::: "memory")
#define PG8_WAIT_L(n) asm volatile("s_waitcnt lgkmcnt(" #n ")" ::: "memory")
#define PG8_BAR __builtin_amdgcn_s_barrier()
#define PG8_SCHED __builtin_amdgcn_sched_barrier(0)
    Unit cur, nxt; int ui = 0;
    if (!S.next(0, cur)) return;
    f32x4 acc[2][2][4][2];
#pragma unroll
    for (int a = 0; a < 2; ++a)
#pragma unroll
        for (int b = 0; b < 2; ++b)
#pragma unroll
            for (int m = 0; m < 4; ++m)
#pragma unroll
                for (int n = 0; n < 2; ++n) acc[a][b][m][n] = (f32x4){0.f, 0.f, 0.f, 0.f};
    bf16x8 At[4][2], B0[2][2], B1[2][2];
    const char* cA = (const char*)(cur.w ? g.A2 : g.A) + (size_t)cur.pm * tstep; const char* cB = (const char*)(cur.w ? g.Bt2 : g.Bt) + (size_t)cur.pn * tstep;
    S.a_ready(cur);
    if constexpr (SP2) {
        PG8_STAGE(PG8_SB(0, 0), cB, voffB); PG8_STAGE(PG8_SB(0, 1), cB + hstep, voffB); PG8_STAGE(PG8_SA(0, 0), cA, voffA); PG8_STAGE(PG8_SA(0, 1), cA + hstep, voffA);
        if (wr == 1) PG8_BAR;
        PG8_WAIT_V(2); PG8_BAR;
        PG8_STAGE(PG8_SB(1, 0), cB + kstep, voffB); PG8_STAGE(PG8_SA(1, 0), cA + kstep, voffA); PG8_STAGE(PG8_SB(1, 1), cB + hstep + kstep, voffB);
        PG8_WAIT_V(6); PG8_BAR;
    } else {
        PG8_STAGE(PG8_SB(0, 0), cB, voffB); PG8_STAGE(PG8_SA(0, 0), cA, voffA); PG8_STAGE(PG8_SB(0, 1), cB + hstep, voffB); PG8_STAGE(PG8_SA(0, 1), cA + hstep, voffA);
        if (wr == 1) PG8_BAR;
        PG8_WAIT_V(4); PG8_BAR;
        PG8_STAGE(PG8_SB(1, 0), cB + kstep, voffB); PG8_STAGE(PG8_SA(1, 0), cA + kstep, voffA); PG8_STAGE(PG8_SB(1, 1), cB + hstep + kstep, voffB);
        PG8_WAIT_V(6); PG8_BAR;
    }
    for (;;) {
        const bool has_next = S.next(ui + 1, nxt);
        const char* nA = has_next ? (const char*)(nxt.w ? g.A2 : g.A) + (size_t)nxt.pm * tstep : cA; const char* nB = has_next ? (const char*)(nxt.w ? g.Bt2 : g.Bt) + (size_t)nxt.pn * tstep : cB;
        for (int t = 0; t < nt; t += 2) {
            const bool last = (t == nt - 2);
            const char* a1 = cA + (size_t)(t + 1) * kstep;
            const char* a2 = last ? nA : cA + (size_t)(t + 2) * kstep; const char* b2 = last ? nB : cB + (size_t)(t + 2) * kstep;
            const char* a3 = a2 + kstep; const char* b3 = b2 + kstep;
            if (last && has_next) S.a_ready(nxt);
            if constexpr (SP2) {
            PG8_LDB(B0, 0, 0); PG8_LDB(B1, 0, 1); PG8_SCHED; PG8_LDA(At, 0, 0); PG8_STAGE(PG8_SA(1, 1), a1 + hstep, voffA);
            PG8_WAIT_V(8); PG8_WAIT_L(0); PG8_BAR; PG8_MMA(0, 0, At, B0); PG8_MMA(0, 1, At, B1); PG8_BAR; PG8_SCHED;
            PG8_LDA(At, 0, 1); PG8_STAGE(PG8_SB(0, 0), b2, voffB); PG8_STAGE(PG8_SB(0, 1), b2 + hstep, voffB); PG8_STAGE(PG8_SA(0, 0), a2, voffA);
            PG8_WAIT_V(8); PG8_WAIT_L(0); PG8_BAR; PG8_MMA(1, 0, At, B0); PG8_MMA(1, 1, At, B1); PG8_BAR; PG8_SCHED;
            PG8_LDB(B0, 1, 0); PG8_LDB(B1, 1, 1); PG8_SCHED; PG8_LDA(At, 1, 0); PG8_STAGE(PG8_SA(0, 1), a2 + hstep, voffA);
            PG8_WAIT_V(8); PG8_WAIT_L(0); PG8_BAR; PG8_MMA(0, 0, At, B0); PG8_MMA(0, 1, At, B1); PG8_BAR; PG8_SCHED;
            PG8_LDA(At, 1, 1); PG8_STAGE(PG8_SB(1, 0), b3, voffB); PG8_STAGE(PG8_SB(1, 1), b3 + hstep, voffB); PG8_STAGE(PG8_SA(1, 0), a3, voffA);
            PG8_WAIT_V(8); PG8_WAIT_L(0); PG8_BAR; PG8_MMA(1, 0, At, B0); PG8_MMA(1, 1, At, B1); PG8_BAR; PG8_SCHED;
            } else {
            PG8_LDB(B0, 0, 0); PG8_SCHED; PG8_LDA(At, 0, 0); PG8_STAGE(PG8_SA(1, 1), a1 + hstep, voffA);
            PG8_WAIT_L(8); PG8_BAR; PG8_WAIT_L(0); PG8_MMA(0, 0, At, B0); PG8_BAR; PG8_SCHED;
            PG8_LDB(B1, 0, 1); PG8_STAGE(PG8_SB(0, 0), b2, voffB);
            PG8_BAR; PG8_WAIT_L(0); PG8_MMA(0, 1, At, B1); PG8_BAR;
            PG8_LDA(At, 0, 1); PG8_STAGE(PG8_SA(0, 0), a2, voffA);
            PG8_BAR; PG8_WAIT_L(0); PG8_MMA(1, 0, At, B0); PG8_BAR; PG8_SCHED;
            PG8_STAGE(PG8_SB(0, 1), b2 + hstep, voffB);
            PG8_WAIT_V(6); PG8_BAR; PG8_MMA(1, 1, At, B1); PG8_BAR;
            PG8_LDB(B0, 1, 0); PG8_SCHED; PG8_LDA(At, 1, 0); PG8_STAGE(PG8_SA(0, 1), a2 + hstep, voffA);
            PG8_WAIT_L(8); PG8_BAR; PG8_WAIT_L(0); PG8_MMA(0, 0, At, B0); PG8_BAR; PG8_SCHED;
            PG8_LDB(B1, 1, 1); PG8_STAGE(PG8_SB(1, 0), b3, voffB);
            PG8_BAR; PG8_WAIT_L(0); PG8_MMA(0, 1, At, B1); PG8_BAR;
            PG8_LDA(At, 1, 1); PG8_STAGE(PG8_SA(1, 0), a3, voffA);
            PG8_BAR; PG8_WAIT_L(0); PG8_MMA(1, 0, At, B0); PG8_BAR; PG8_SCHED;
            PG8_STAGE(PG8_SB(1, 1), b3 + hstep, voffB);
            PG8_WAIT_V(6); PG8_BAR; PG8_MMA(1, 1, At, B1); PG8_BAR;
            }
        }
        if constexpr (ALIGN_EPI) { if (wr == 0) PG8_BAR; }
        if constexpr (!Epi::AFTER_DRAIN) { E(acc, cur, wr, wc, fr, fq); S.done(cur); }
        if (!has_next) break;
#pragma unroll
        for (int a = 0; a < 2; ++a)
#pragma unroll
            for (int b = 0; b < 2; ++b)
#pragma unroll
                for (int m = 0; m < 4; ++m)
#pragma unroll
                    for (int n = 0; n < 2; ++n) acc[a][b][m][n] = (f32x4){0.f, 0.f, 0.f, 0.f};
        cur = nxt; cA = nA; cB = nB; ++ui;
        if constexpr (ALIGN_EPI) { if (wr == 1) PG8_BAR; }
    }
    PG8_WAIT_V(0);
    if constexpr (!ALIGN_EPI) { if (wr == 0) PG8_BAR; }
    PG8_BAR;
    if constexpr (Epi::AFTER_DRAIN) { E.fused(acc, cur, wr, wc, fr, fq, lds, wid, lane); S.done(cur); }
#undef PG8_SA
#undef PG8_SB
#undef PG8_STAGE
#undef PG8_LDA
#undef PG8_LDB
#undef PG8_MMA
#undef PG8_WAIT_V
#undef PG8_WAIT_L
#undef PG8_BAR
#undef PG8_SCHED
}
}

constexpr int BATCH = 16, SEQ = 2048, DM = 1024, MTOK = BATCH * SEQ, NQKV = 1536, FF = 2816, NH = 16, NKV = 4, HD = 64;
constexpr float RMS_EPS = 1e-6f, LOG2E = 1.4426950408889634f;
constexpr int NWAVES = 8;
#define LAS __attribute__((address_space(3)))
typedef unsigned short bf16;
typedef float f32x4 __attribute__((ext_vector_type(4)));
typedef float f32x16 __attribute__((ext_vector_type(16)));
typedef unsigned u32x4 __attribute__((ext_vector_type(4)));
typedef unsigned u32x2 __attribute__((ext_vector_type(2)));
typedef short bf16x8 __attribute__((ext_vector_type(8)));

constexpr size_t MiB = 1u << 20;
constexpr size_t WS_WQKV = 0, WS_WO = 3 * MiB, WS_WIN = 5 * MiB, WS_WOUT = 11 * MiB, WS_WGU = 13 * MiB  , WS_WD = 35 * MiB  ;
constexpr size_t WS_ROPE = 46 * MiB;
constexpr size_t WS_CTL = 46 * MiB + 768 * 1024;
constexpr size_t WS_RS = 46 * MiB + 832 * 1024;
constexpr size_t WS_XNB = 47 * MiB;
constexpr size_t WS_GH = 48 * MiB;
constexpr size_t WS_XN = 52 * MiB;
constexpr size_t WS_Y = 116 * MiB;
constexpr size_t WS_ACT = 180 * MiB;
constexpr size_t WS_Q = 180 * MiB, WS_K = 244 * MiB, WS_VT = 260 * MiB;
constexpr size_t WS_P = 180 * MiB, WS_Y2 = 244 * MiB;
constexpr size_t WS_END = 356 * MiB;

constexpr int LDS_BYTES = 147456, LDS_BARST = 131072 + 64, LDS_XCH = 131072 + 1024;
constexpr int BAR_WORDS = 3456;

__device__ __forceinline__ unsigned f2bf(float f) { unsigned u = __builtin_bit_cast(unsigned, f); return (u + 0x7fffu + ((u >> 16) & 1u)) >> 16; }
__device__ __forceinline__ unsigned pk2(float lo, float hi) { return f2bf(lo) | (f2bf(hi) << 16); }
__device__ __forceinline__ float wave_sum(float v) {
#pragma unroll
    for (int o = 1; o < 64; o <<= 1) v += __shfl_xor(v, o);
    return v;
}

#define RLX_AGENT __ATOMIC_RELAXED, __HIP_MEMORY_SCOPE_AGENT
#define XB_TMO      128
#define XB_XCNT(j)  (256  + 64 * (j))
#define XB_XSUB(j)  (1280 + 64 * (j))
#define XB_XGEN(j)  (2304 + 64 * (j))
#define XB_TOP      3328
#define XB_TOPGEN   3392
#define XCD_BAR_WORDS 3456
#define XB_SPIN_CAP (1u << 18)

__device__ __forceinline__ unsigned xb_ld(unsigned* p)              { return __hip_atomic_load(p, __ATOMIC_RELAXED, __HIP_MEMORY_SCOPE_AGENT); }
__device__ __forceinline__ unsigned xb_add(unsigned* p, unsigned v) { return __hip_atomic_fetch_add(p, v, __ATOMIC_RELAXED, __HIP_MEMORY_SCOPE_AGENT); }
__device__ __forceinline__ unsigned xb_xcc_id() { return (unsigned)__builtin_amdgcn_s_getreg((3 << 11) | 20) & 0xFu; }
#define XB_SPIN(cond, bar) do { unsigned _sp = 0; while (cond) { __builtin_amdgcn_s_sleep(1); \
    if ((++_sp & 255u) == 0u) { if (xb_ld(&(bar)[XB_TMO])) break; if (_sp > XB_SPIN_CAP) { atomicAdd(&(bar)[XB_TMO], 1u); break; } } } } while (0)

struct XcdBarrier {
    unsigned* bar; unsigned x;
    volatile LAS unsigned* st;
};

__device__ __forceinline__ XcdBarrier xcd_barrier_post(unsigned* bar, volatile LAS unsigned* st) {
    XcdBarrier b; b.bar = bar; b.x = xb_xcc_id(); b.st = st;
    if (threadIdx.x == 0) (void)xb_add(&bar[XB_XCNT(b.x)], 1u);
    return b;
}
__device__ __forceinline__ void xcd_barrier_complete(unsigned* bar, unsigned x, unsigned& nloc, unsigned& nx) {
    const unsigned G = gridDim.x * gridDim.y * gridDim.z;
    unsigned sum, cnt, mine, sp = 0u;
    for (;;) {
        sum = 0u; cnt = 0u; mine = 0u;
#pragma unroll
        for (unsigned j = 0; j < 16; ++j) { const unsigned c = xb_ld(&bar[XB_XCNT(j)]); sum += c; cnt += (c > 0u) ? 1u : 0u; mine = (j == x) ? c : mine; }
        if (sum == G) break;
        __builtin_amdgcn_s_sleep(1);
        if ((++sp & 255u) == 0u) { if (xb_ld(&bar[XB_TMO])) break; if (sp > XB_SPIN_CAP) { atomicAdd(&bar[XB_TMO], 1u); break; } }
    }
    nloc = mine > 0u ? mine : 1u; nx = cnt > 0u ? cnt : 1u;
}

__device__ __forceinline__ void xcd_barrier(const XcdBarrier& b) {
    asm volatile("s_waitcnt vmcnt(0)" ::: "memory");
    __syncthreads();
    if (threadIdx.x == 0) {
        unsigned* bar = b.bar;
        __builtin_amdgcn_s_waitcnt(0);
        unsigned nloc = b.st[0], nx = b.st[1];
        if (nloc == 0u) { xcd_barrier_complete(bar, b.x, nloc, nx); b.st[0] = nloc; b.st[1] = nx; }
        const unsigned old = xb_add(&bar[XB_XSUB(b.x)], 1u);
        const unsigned gen = old / nloc;
        if (old + 1u == (gen + 1u) * nloc) {
            __builtin_amdgcn_fence(__ATOMIC_RELEASE, "agent");
            asm volatile("s_waitcnt vmcnt(0)" ::: "memory");
            const unsigned og = xb_add(&bar[XB_TOP], 1u);
            const unsigned tg = og / nx;
            if (og + 1u == (tg + 1u) * nx) xb_add(&bar[XB_TOPGEN], 1u);
            else XB_SPIN(xb_ld(&bar[XB_TOPGEN]) == tg, bar);
            __builtin_amdgcn_fence(__ATOMIC_ACQUIRE, "agent");
            xb_add(&bar[XB_XGEN(b.x)], 1u);
            asm volatile("s_waitcnt vmcnt(0)" ::: "memory");
        } else {
            XB_SPIN(xb_ld(&bar[XB_XGEN(b.x)]) == gen, bar);
            __builtin_amdgcn_fence(__ATOMIC_ACQUIRE, "agent");
            asm volatile("s_waitcnt vmcnt(0)" ::: "memory");
        }
    }
    __syncthreads();
}

namespace att {
constexpr int KSTR = 144, VSTR = 776, LDS_K = 0, LDS_V = 384 * KSTR;
__device__ __forceinline__ int crow(int r, int hi) { return (r & 3) + 8 * (r >> 2) + 4 * hi; }
#define MFMA32(a, b, c) __builtin_amdgcn_mfma_f32_32x32x16_bf16((a), (b), (c), 0, 0, 0)
__device__ __forceinline__ void attn_phase(LAS unsigned char* lds, const bf16* Q, bf16* O, const bf16* Kg, const bf16* Vt, const float* sink) {
    int tid_ = threadIdx.x; asm volatile("" : "+v"(tid_));
    const int tid = tid_, lane = tid & 63, wid = __builtin_amdgcn_readfirstlane(tid >> 6), i32 = lane & 31, hi = lane >> 5;
    for (int u = blockIdx.x; u < BATCH * 16 * NKV; u += gridDim.x) {
        const int kvh = u & 3, blk = (u >> 2) & 15, b = u >> 6;
        const int tlo = blk == 0 ? 128 : 0, thi = blk == 15 ? 256 : 384;
        const long tok0 = (long)b * SEQ + blk * 128 - 128;
#pragma unroll
        for (int j = 0; j < 6; ++j) { const int id = tid + 512 * j, t = id >> 3, c = id & 7;
            if (t >= tlo && t < thi) { const u32x4 v = *(const u32x4*)(Kg + (tok0 + t) * 256 + kvh * 64 + c * 8); *(LAS u32x4*)(lds + LDS_K + t * KSTR + c * 16) = v; } }
#pragma unroll
        for (int j = 0; j < 6; ++j) { const int id = tid + 512 * j, d = id / 48, ch = id % 48, t = ch * 8;
            if (t >= tlo && t < thi) { const u32x4 v = *(const u32x4*)(Vt + (size_t)(kvh * 64 + d) * MTOK + tok0 + t);
                LAS u32x2* p = (LAS u32x2*)(lds + LDS_V + d * VSTR + ch * 16); p[0] = (u32x2){v.x, v.y}; p[1] = (u32x2){v.z, v.w}; } }
        __syncthreads();
        const int g = wid >> 1, r0 = (wid & 1) * 64, h = kvh * 4 + g;
        const long qrow0 = (long)b * SEQ + blk * 128 + r0;
        bf16x8 qf[2][4];
#pragma unroll
        for (int qt = 0; qt < 2; ++qt)
#pragma unroll
            for (int dc = 0; dc < 4; ++dc) qf[qt][dc] = *(const bf16x8*)(Q + (qrow0 + qt * 32 + i32) * 1024 + h * 64 + dc * 16 + hi * 8);
        f32x16 o[2][2];
#pragma unroll
        for (int a = 0; a < 2; ++a)
#pragma unroll
            for (int c = 0; c < 2; ++c)
#pragma unroll
                for (int r = 0; r < 16; ++r) o[a][c][r] = 0.f;
        const float sink2 = sink[h] * LOG2E;
        float mrun[2] = {sink2, sink2}, lrun[2] = {0.f, 0.f};
        const int ktlo = (tlo > r0 ? tlo : r0) >> 5, kthi = (thi < r0 + 320 ? thi : r0 + 320) >> 5;
        for (int kt = ktlo; kt < kthi; ++kt) {
            const int t0 = kt * 32;
            f32x16 s[2];
#pragma unroll
            for (int r = 0; r < 16; ++r) { s[0][r] = -mrun[0]; s[1][r] = -mrun[1]; }
#pragma unroll
            for (int dc = 0; dc < 4; ++dc) { const bf16x8 kf = *(const LAS bf16x8*)(lds + LDS_K + (t0 + i32) * KSTR + dc * 32 + hi * 16);
                s[0] = MFMA32(kf, qf[0][dc], s[0]); s[1] = MFMA32(kf, qf[1][dc], s[1]); }
            bf16x8 vf[2][2];
#pragma unroll
            for (int dt = 0; dt < 2; ++dt)
#pragma unroll
                for (int c = 0; c < 2; ++c) { const LAS unsigned char* vp = lds + LDS_V + (dt * 32 + i32) * VSTR + (t0 + 16 * c + 4 * hi) * 2;
                    const u32x2 lo = *(const LAS u32x2*)vp, hh = *(const LAS u32x2*)(vp + 16); vf[dt][c] = __builtin_bit_cast(bf16x8, (u32x4){lo.x, lo.y, hh.x, hh.y}); }
            const bool full = (t0 >= r0 + 63) && (t0 + 31 <= r0 + 256);
            if (!full) {
#pragma unroll
                for (int qt = 0; qt < 2; ++qt) { const int rq = r0 + qt * 32 + i32;
#pragma unroll
                    for (int r = 0; r < 16; ++r) { const int t = t0 + crow(r, hi); if (t < rq || t > rq + 256) s[qt][r] = -1e30f; } }
            }
#pragma unroll
            for (int qt = 0; qt < 2; ++qt) {
                float mx = s[qt][0];
#pragma unroll
                for (int r = 1; r < 16; ++r) mx = fmaxf(mx, s[qt][r]);
                mx = fmaxf(mx, __shfl_xor(mx, 32));
                if (__any(mx > 8.0f)) {
                    const float dl = fmaxf(mx, 0.f), alpha = __builtin_amdgcn_exp2f(-dl);
                    mrun[qt] += dl; lrun[qt] *= alpha;
#pragma unroll
                    for (int r = 0; r < 16; ++r) { s[qt][r] -= dl; o[qt][0][r] *= alpha; o[qt][1][r] *= alpha; }
                }
                float ls = 0.f;
#pragma unroll
                for (int r = 0; r < 16; ++r) { const float p = __builtin_amdgcn_exp2f(s[qt][r]); s[qt][r] = p; ls += p; }
                lrun[qt] += ls;
                u32x4 p0, p1;
                p0.x = pg8::cvt_pk_bf16(s[qt][0], s[qt][1]); p0.y = pg8::cvt_pk_bf16(s[qt][2], s[qt][3]); p0.z = pg8::cvt_pk_bf16(s[qt][4], s[qt][5]); p0.w = pg8::cvt_pk_bf16(s[qt][6], s[qt][7]);
                p1.x = pg8::cvt_pk_bf16(s[qt][8], s[qt][9]); p1.y = pg8::cvt_pk_bf16(s[qt][10], s[qt][11]); p1.z = pg8::cvt_pk_bf16(s[qt][12], s[qt][13]); p1.w = pg8::cvt_pk_bf16(s[qt][14], s[qt][15]);
                const bf16x8 pf0 = __builtin_bit_cast(bf16x8, p0), pf1 = __builtin_bit_cast(bf16x8, p1);
#pragma unroll
                for (int dt = 0; dt < 2; ++dt) { o[qt][dt] = MFMA32(vf[dt][0], pf0, o[qt][dt]); o[qt][dt] = MFMA32(vf[dt][1], pf1, o[qt][dt]); }
            }
        }
#pragma unroll
        for (int qt = 0; qt < 2; ++qt) {
            const float lt = lrun[qt] + __shfl_xor(lrun[qt], 32) + __builtin_amdgcn_exp2f(sink2 - mrun[qt]);
            const float inv = 1.0f / lt;
            bf16* orow = O + (qrow0 + qt * 32 + i32) * 1024 + h * 64 + 4 * hi;
#pragma unroll
            for (int dt = 0; dt < 2; ++dt)
#pragma unroll
                for (int r4 = 0; r4 < 4; ++r4) { u32x2 w; w.x = pg8::cvt_pk_bf16(o[qt][dt][4 * r4] * inv, o[qt][dt][4 * r4 + 1] * inv); w.y = pg8::cvt_pk_bf16(o[qt][dt][4 * r4 + 2] * inv, o[qt][dt][4 * r4 + 3] * inv);
                    *(u32x2*)(orow + dt * 32 + 8 * r4) = w; }
        }
        __syncthreads();
    }
}
}

template <bool FIRST, bool LAST>
__device__ __forceinline__ void seam_pass(const float* xin, bf16* hb, const bf16* y, const float* gpost, float* outp, float* rs, bf16* xnb) {
    int tid_ = threadIdx.x; asm volatile("" : "+v"(tid_)); const int lane = tid_ & 63, wave = __builtin_amdgcn_readfirstlane(tid_ >> 6);
    const int gw = blockIdx.x * NWAVES + wave, NGW = gridDim.x * NWAVES;
    f32x4 g[4];
#pragma unroll
    for (int j = 0; j < 4; ++j) g[j] = *(const f32x4*)(gpost + 4 * lane + 256 * j);
    for (int row0 = 2 * gw; row0 < MTOK; row0 += 2 * NGW) {
        f32x4 yv[2][4], hv[2][4];
#pragma unroll
        for (int q = 0; q < 2; ++q) { const size_t off = (size_t)(row0 + q) * DM + 4 * lane;
#pragma unroll
            for (int j = 0; j < 4; ++j) { const u32x2 w = *(const u32x2*)(y + off + 256 * j);
                yv[q][j] = (f32x4){__uint_as_float(w.x << 16), __uint_as_float(w.x & 0xffff0000u), __uint_as_float(w.y << 16), __uint_as_float(w.y & 0xffff0000u)};
                if (FIRST) hv[q][j] = *(const f32x4*)(xin + off + 256 * j);
                else { const u32x2 hw = *(const u32x2*)(hb + off + 256 * j);
                    hv[q][j] = (f32x4){__uint_as_float(hw.x << 16), __uint_as_float(hw.x & 0xffff0000u), __uint_as_float(hw.y << 16), __uint_as_float(hw.y & 0xffff0000u)}; } } }
#pragma unroll
        for (int q = 0; q < 2; ++q) { const int row = row0 + q; const size_t off = (size_t)row * DM + 4 * lane;
            float ss = 0.f;
#pragma unroll
            for (int j = 0; j < 4; ++j) ss += (yv[q][j][0] * yv[q][j][0] + yv[q][j][1] * yv[q][j][1]) + (yv[q][j][2] * yv[q][j][2] + yv[q][j][3] * yv[q][j][3]);
            const float a = 1.0f / sqrtf(wave_sum(ss) * (1.0f / DM) + RMS_EPS);
            float s2 = 0.f;
#pragma unroll
            for (int j = 0; j < 4; ++j) { const f32x4 hn = hv[q][j] + (yv[q][j] * a) * g[j];
                if (LAST) *(f32x4*)(outp + off + 256 * j) = hn;
                else { u32x2 w; w.x = pk2(hn[0], hn[1]); w.y = pk2(hn[2], hn[3]); *(u32x2*)(hb + off + 256 * j) = w;
                    s2 += (hn[0] * hn[0] + hn[1] * hn[1]) + (hn[2] * hn[2] + hn[3] * hn[3]);
                    const int rl = row & 255;
                    if (rl == 255 && row + 1 < MTOK) *(u32x2*)(xnb + (size_t)(2 * ((row + 1) >> 8)) * DM + 4 * lane + 256 * j) = w;
                    if (rl == 0) *(u32x2*)(xnb + (size_t)(2 * (row >> 8) + 1) * DM + 4 * lane + 256 * j) = w; } }
            if (!LAST) { const float r2 = 1.0f / sqrtf(wave_sum(s2) * (1.0f / DM) + RMS_EPS); if (lane == 0) rs[row] = r2; }
        }
    }
}
__device__ __forceinline__ void cast_rows(const float* x, bf16* hb, float* rs) {
    int tid_ = threadIdx.x; asm volatile("" : "+v"(tid_)); const int lane = tid_ & 63, wave = __builtin_amdgcn_readfirstlane(tid_ >> 6);
    const int gw = blockIdx.x * NWAVES + wave, NGW = gridDim.x * NWAVES;
    for (int row0 = 2 * gw; row0 < MTOK; row0 += 2 * NGW) {
        f32x4 v[2][4];
#pragma unroll
        for (int q = 0; q < 2; ++q)
#pragma unroll
            for (int j = 0; j < 4; ++j) v[q][j] = *(const f32x4*)(x + (size_t)(row0 + q) * DM + 4 * lane + 256 * j);
#pragma unroll
        for (int q = 0; q < 2; ++q) { const size_t off = (size_t)(row0 + q) * DM + 4 * lane; float ss = 0.f;
#pragma unroll
            for (int j = 0; j < 4; ++j) { ss += (v[q][j][0] * v[q][j][0] + v[q][j][1] * v[q][j][1]) + (v[q][j][2] * v[q][j][2] + v[q][j][3] * v[q][j][3]);
                u32x2 w; w.x = pk2(v[q][j][0], v[q][j][1]); w.y = pk2(v[q][j][2], v[q][j][3]); *(u32x2*)(hb + off + 256 * j) = w; }
            const float r = 1.0f / sqrtf(wave_sum(ss) * (1.0f / DM) + RMS_EPS); if (lane == 0) rs[row0 + q] = r; }
    }
}

__device__ __forceinline__ int map_col(int mode, int n) {
    if (mode == 1) {
        if (n >= 1280) return n;
        const int p = n & 63, j = p >> 3, e = p & 7; return (n & ~63) + (e < 4 ? 4 * j + e : 32 + 4 * j + (e - 4));
    }
    if (mode == 2) {
        if (n >= 2048) return n - 2048;
        const int j = n >> 8, hsel = (n >> 7) & 1, i = n & 127; return 1024 + hsel * 1024 + 128 * j + i;
    }
    if (mode == 3) { const int j = n >> 8, hsel = (n >> 7) & 1, i = n & 127; return hsel * FF + 128 * j + i; }
    return n;
}
__device__ __forceinline__ void transpose_item(const float* W, int K, int N, bf16* WT, int mode, const float* gain, LAS float* scr, int item, int lane) {
    const int nblk = N / 32, kb = item / nblk, nb = item % nblk, k0 = 64 * kb, n0 = 32 * nb;
    const int src = map_col(mode, n0 + (lane & 31));
#pragma unroll 8
    for (int i = 0; i < 32; ++i) { const int kk = 2 * i + (lane >> 5); scr[kk * 33 + (lane & 31)] = W[(size_t)(k0 + kk) * N + src] * (gain ? gain[k0 + kk] : 1.0f); }
    asm volatile("s_waitcnt lgkmcnt(0)" ::: "memory");
    const int c = lane & 7;
#pragma unroll
    for (int j = 0; j < 4; ++j) { const int n = (lane >> 3) + 8 * j; const LAS float* s = scr + (8 * c) * 33 + n;
        u32x4 o; o.x = pk2(s[0 * 33], s[1 * 33]); o.y = pk2(s[2 * 33], s[3 * 33]); o.z = pk2(s[4 * 33], s[5 * 33]); o.w = pk2(s[6 * 33], s[7 * 33]);
        *(u32x4*)(WT + (size_t)(n0 + n) * K + k0 + 8 * c) = o; }
    asm volatile("s_waitcnt lgkmcnt(0)" ::: "memory");
}
__device__ const float INV_FREQ[32] = {1.000000000e+00f, 7.498942614e-01f, 5.623413324e-01f, 4.216965139e-01f, 3.162277639e-01f, 2.371373773e-01f, 1.778279394e-01f, 1.333521307e-01f, 1.000000015e-01f, 7.498941571e-02f, 5.623413250e-02f, 4.216965288e-02f, 3.162277490e-02f, 2.371373773e-02f, 1.778279431e-02f, 1.333521493e-02f, 9.999999776e-03f, 7.498941850e-03f, 5.623413250e-03f, 4.216964822e-03f, 3.162277630e-03f, 2.371373586e-03f, 1.778279431e-03f, 1.333521446e-03f, 1.000000047e-03f, 7.498942432e-04f, 5.623413017e-04f, 4.216965172e-04f, 3.162277571e-04f, 2.371373703e-04f, 1.778279402e-04f, 1.333521504e-04f};
__device__ __forceinline__ void sincos_f64(float angf, float& c, float& s) {
    const double a = (double)angf, k = __builtin_rint(a * 0.63661977236758134308);
    double r = __builtin_fma(-k, 1.57079632679489655800e+00, a); r = __builtin_fma(-k, 6.12323399573676603587e-17, r);
    const double r2 = r * r;
    double sp = -1.0 / 1307674368000.0; sp = sp * r2 + 1.0 / 6227020800.0; sp = sp * r2 - 1.0 / 39916800.0; sp = sp * r2 + 1.0 / 362880.0; sp = sp * r2 - 1.0 / 5040.0; sp = sp * r2 + 1.0 / 120.0; sp = sp * r2 - 1.0 / 6.0; sp = sp * r2 + 1.0;
    double cp = 1.0 / 20922789888000.0; cp = cp * r2 - 1.0 / 87178291200.0; cp = cp * r2 + 1.0 / 479001600.0; cp = cp * r2 - 1.0 / 3628800.0; cp = cp * r2 + 1.0 / 40320.0; cp = cp * r2 - 1.0 / 720.0; cp = cp * r2 + 1.0 / 24.0; cp = cp * r2 - 0.5; cp = cp * r2 + 1.0;
    const double sr = sp * r, cr = cp; const int q = (int)((long long)k & 3);
    const double cc = (q == 0) ? cr : (q == 1) ? -sr : (q == 2) ? -cr : sr;
    const double sv = (q == 0) ? sr : (q == 1) ? cr : (q == 2) ? -sr : -cr;
    c = (float)cc; s = (float)sv;
}

#ifndef PHASES
#define PHASES 0xffff
#endif
#define PH(k) ((PHASES >> (k)) & 1)
#ifndef DUP_MASK
#define DUP_MASK 0
#endif
#define REP(k) for (int rep_ = 0; rep_ < 1 + ((DUP_MASK >> (k)) & 1); ++rep_)
struct Args { const float* in[12]; float* out; unsigned char* ws; };

typedef const Args __attribute__((address_space(4)))* ArgsP;
#define PTRS ArgsP ap_ = (ArgsP)__builtin_amdgcn_kernarg_segment_ptr(); asm volatile("" : "+s"(ap_)); \
    unsigned char* ws = ap_->ws; (void)ws; \
    const float* x = ap_->in[0]; const int* positions = (const int*)ap_->in[1]; const float* w_qkv = ap_->in[2]; const float* sink = ap_->in[3]; const float* w_o = ap_->in[4]; \
    const float* w_in = ap_->in[5]; const float* conv_w = ap_->in[6]; const float* w_out = ap_->in[7]; const float* gains = ap_->in[8]; const float* w_gu = ap_->in[9]; \
    const float* ffn_cw = ap_->in[10]; const float* w_dn = ap_->in[11]; float* out = ap_->out; \
    bf16* Wqkv_t = (bf16*)(ws + WS_WQKV); bf16* Wo_t = (bf16*)(ws + WS_WO); bf16* Win_t = (bf16*)(ws + WS_WIN); bf16* Wout_t = (bf16*)(ws + WS_WOUT); \
    bf16* Wgu_t = (bf16*)(ws + WS_WGU); bf16* Wd_t = (bf16*)(ws + WS_WD); float* rcos = (float*)(ws + WS_ROPE); float* rsin = rcos + SEQ * 32; \
    float* RS = (float*)(ws + WS_RS); (void)RS; bf16* XN = (bf16*)(ws + WS_XN); bf16* XNB = (bf16*)(ws + WS_XNB); bf16* GH = (bf16*)(ws + WS_GH); (void)XNB; (void)GH; bf16* Y = (bf16*)(ws + WS_Y); bf16* ACT = (bf16*)(ws + WS_ACT); \
    bf16* QB = (bf16*)(ws + WS_Q); bf16* KB = (bf16*)(ws + WS_K); bf16* VT = (bf16*)(ws + WS_VT); bf16* PB = (bf16*)(ws + WS_P); bf16* Y2 = (bf16*)(ws + WS_Y2); \
    (void)x; (void)positions; (void)w_qkv; (void)sink; (void)w_o; (void)w_in; (void)conv_w; (void)w_out; (void)gains; (void)w_gu; (void)ffn_cw; (void)w_dn; (void)out; \
    (void)Wqkv_t; (void)Wo_t; (void)Win_t; (void)Wout_t; (void)Wgu_t; (void)Wd_t; (void)rcos; (void)rsin; (void)XN; (void)Y; (void)ACT; (void)QB; (void)KB; (void)VT; (void)PB; (void)Y2; \
    const int G = gridDim.x; (void)G

__global__ void __launch_bounds__(NWAVES * 64, 2) fwd_megakernel(Args args) {
    extern __shared__ __attribute__((aligned(16))) unsigned char lds_raw[];
    LAS unsigned char* lds = (LAS unsigned char*)lds_raw;
    cg::grid_group grid = cg::this_grid();
#define SYNC() do { ArgsP bp_ = (ArgsP)__builtin_amdgcn_kernarg_segment_ptr(); XcdBarrier b_; b_.bar = (unsigned*)(bp_->ws + WS_CTL); b_.x = xb_xcc_id(); b_.st = (volatile LAS unsigned*)(lds + LDS_BARST); xcd_barrier(b_); } while (0)
    if (threadIdx.x == 0) { ((volatile LAS unsigned*)(lds + LDS_BARST))[0] = 0u; ((volatile LAS unsigned*)(lds + LDS_BARST))[1] = 0u; }
    if (blockIdx.x == 0) { unsigned* ctl = (unsigned*)(args.ws + WS_CTL); for (int i = threadIdx.x; i < BAR_WORDS; i += NWAVES * 64) ctl[i] = 0u; }
    __syncthreads();

    REP(0) if (PH(0)) {
        PTRS;
        int tid_ = threadIdx.x; asm volatile("" : "+v"(tid_)); const int tid = tid_, lane = tid & 63, wave = __builtin_amdgcn_readfirstlane(tid >> 6);
        LAS float* scr = (LAS float*)(lds + wave * 16384);
        const int gw = blockIdx.x * NWAVES + wave, NGW = G * NWAVES;
        constexpr int I_QKV = 16 * (NQKV / 32), I_O = 16 * 32, I_IN = 16 * 96, I_OUT = 16 * 32, I_GU = 16 * (2 * FF / 32), I_D = (FF / 64) * 32;
        constexpr int NITEMS = I_QKV + I_O + I_IN + I_OUT + 2 * I_GU + 2 * I_D;
        for (int it = gw; it < NITEMS; it += NGW) {
            int r = it;
            if (r < I_QKV) { transpose_item(w_qkv, DM, NQKV, Wqkv_t, 1, gains, scr, r, lane); continue; } r -= I_QKV;
            if (r < I_O) { transpose_item(w_o, DM, DM, Wo_t, 0, nullptr, scr, r, lane); continue; } r -= I_O;
            if (r < I_IN) { transpose_item(w_in, DM, 3 * DM, Win_t, 2, gains + 4 * DM, scr, r, lane); continue; } r -= I_IN;
            if (r < I_OUT) { transpose_item(w_out, DM, DM, Wout_t, 0, nullptr, scr, r, lane); continue; } r -= I_OUT;
            if (r < I_GU) { transpose_item(w_gu, DM, 2 * FF, Wgu_t, 3, gains + 2 * DM, scr, r, lane); continue; } r -= I_GU;
            if (r < I_GU) { transpose_item(w_gu + (size_t)DM * 2 * FF, DM, 2 * FF, Wgu_t + (size_t)2 * FF * DM, 3, gains + 6 * DM, scr, r, lane); continue; } r -= I_GU;
            if (r < I_D) { transpose_item(w_dn, FF, DM, Wd_t, 0, nullptr, scr, r, lane); continue; } r -= I_D;
            transpose_item(w_dn + (size_t)FF * DM, FF, DM, Wd_t + (size_t)DM * FF, 0, nullptr, scr, r, lane);
        }
        for (int e = blockIdx.x * (NWAVES * 64) + tid; e < SEQ * 32; e += G * NWAVES * 64) {
            const int s = e >> 5, i = e & 31; const float ang = (float)positions[s] * INV_FREQ[i];
            float c, sn; sincos_f64(ang, c, sn); rcos[e] = c; rsin[e] = sn;
        }
        cast_rows(x, XN, RS);
    }
    grid.sync();
    if (threadIdx.x == 0) (void)xb_add(&((unsigned*)(args.ws + WS_CTL))[XB_XCNT(xb_xcc_id())], 1u);
    REP(1) if (PH(1)) {
        PTRS;
        pg8::Gemm g{XN, Wqkv_t, MTOK, 1280, DM, Wqkv_t + (size_t)1280 * DM, XN}; pg8::StaticOrder S; S.init(MTOK, 1280, G, (int)blockIdx.x, MTOK / 256);
        pg8::EpiQKV E{QB, (long)((WS_K - WS_Q) / 2), (long)((WS_VT - WS_Q) / 2), rcos, rsin, RS, 0.125f * LOG2E, MTOK};
        pg8::gemm_phase<pg8::EpiQKV, pg8::StaticOrder, true, true>(lds, g, S, E);
    }
    SYNC();
#ifdef PROBE_ATT2
    { PTRS; att::attn_phase(lds, QB, (bf16*)(ws + WS_END), KB, VT, sink); }
#endif
    if (PH(2)) { PTRS; att::attn_phase(lds, QB, QB, KB, VT, sink); }
    SYNC();
    REP(3) if (PH(3)) {
        PTRS;
        pg8::Gemm g{QB, Wo_t, MTOK, DM, DM, nullptr, nullptr}; pg8::StaticOrder S; S.init(MTOK, DM, G, (int)blockIdx.x);
        pg8::EpiStore E{Y, DM};
        pg8::gemm_phase<pg8::EpiStore, pg8::StaticOrder, true, true>(lds, g, S, E);
    }
    SYNC();
    REP(4) if (PH(4)) { PTRS; seam_pass<true, false>(x, XN, Y, gains + 1 * DM, nullptr, RS, XNB); }
    SYNC();
#pragma unroll 1
    for (int layer = 0; layer < 2; ++layer) {
        if (PH(5) && layer == 1) {
            REP(7) if (PH(7)) {
                PTRS;
                pg8::Gemm g{XN, Win_t, MTOK, 2048, DM, nullptr, nullptr}; pg8::StaticOrder S; S.init(MTOK, 2048, G, (int)blockIdx.x);
                pg8::EpiCX E{PB, RS};
                pg8::gemm_phase<pg8::EpiCX, pg8::StaticOrder, true, true>(lds, g, S, E);
            }
            SYNC();
            REP(8) if (PH(8)) {
                PTRS;
                pg8::Gemm g{XN, Win_t + (size_t)2048 * DM, MTOK, DM, DM, nullptr, nullptr}; pg8::StaticOrder S; S.init(MTOK, DM, G, (int)blockIdx.x);
                pg8::EpiConv<0> E{PB, conv_w, Y2, DM, RS};
                pg8::gemm_phase<pg8::EpiConv<0>, pg8::StaticOrder, true, true>(lds, g, S, E);
            }
            SYNC();
            REP(9) if (PH(9)) {
                PTRS;
                pg8::Gemm g{Y2, Wout_t, MTOK, DM, DM, nullptr, nullptr}; pg8::StaticOrder S; S.init(MTOK, DM, G, (int)blockIdx.x);
                pg8::EpiStore E{Y, DM};
                pg8::gemm_phase<pg8::EpiStore, pg8::StaticOrder, true, true>(lds, g, S, E);
            }
            SYNC();
            { PTRS; seam_pass<false, false>(nullptr, XN, Y, gains + 5 * DM, nullptr, RS, XNB); }
            SYNC();
        }
        if (!PH(6)) continue;
        REP(10) if (PH(10)) {
            PTRS; const bf16* Wg = Wgu_t + (size_t)layer * 2 * FF * DM;
            pg8::Gemm g{XNB, Wg, 256, 2 * FF, DM, nullptr, nullptr}; pg8::StaticOrder S; S.init(256, 2 * FF, G, (int)blockIdx.x);
            pg8::EpiStore E{GH, 2 * FF};
            pg8::gemm_phase<pg8::EpiStore, pg8::StaticOrder, true, true>(lds, g, S, E);
        }
        SYNC();
        REP(11) if (PH(11)) {
            PTRS; const bf16* Wg = Wgu_t + (size_t)layer * 2 * FF * DM;
            pg8::Gemm g{XN, Wg, MTOK, 2 * FF, DM, nullptr, nullptr}; pg8::StaticOrder S; S.init(MTOK, 2 * FF, G, (int)blockIdx.x);
            pg8::EpiGU E{GH, ffn_cw + (size_t)layer * 3 * FF, ACT, lds + LDS_XCH, FF, RS};
            pg8::gemm_phase<pg8::EpiGU, pg8::StaticOrder, true, true>(lds, g, S, E);
        }
        SYNC();
#ifdef PROBE_PLAINUP
        if (layer == 0) {
            PTRS; const bf16* Wg = Wgu_t + (size_t)layer * 2 * FF * DM;
            pg8::Gemm g{XN, Wg, MTOK, 2 * FF, DM, nullptr, nullptr}; pg8::StaticOrder S; S.init(MTOK, 2 * FF, G, (int)blockIdx.x);
            pg8::EpiStore E{(bf16*)(ws + WS_END), DM};
            pg8::gemm_phase<pg8::EpiStore, pg8::StaticOrder, true, true>(lds, g, S, E);
        }
#endif
        REP(12) if (PH(12)) {
            PTRS; const bf16* Wd = Wd_t + (size_t)layer * DM * FF;
            pg8::Gemm g{ACT, Wd, MTOK, DM, FF, nullptr, nullptr}; pg8::StaticOrder S; S.init(MTOK, DM, G, (int)blockIdx.x);
            pg8::EpiStore E{Y, DM};
            pg8::gemm_phase<pg8::EpiStore, pg8::StaticOrder, true, true>(lds, g, S, E);
        }
        SYNC();
        { PTRS; if (layer == 0) seam_pass<false, false>(nullptr, XN, Y, gains + 3 * DM, nullptr, RS, XNB); else seam_pass<false, true>(nullptr, XN, Y, gains + 7 * DM, out, nullptr, nullptr); }
        if (layer == 0) SYNC();
    }
}

extern "C" void kernel_launch(void* const* d_in, const int* in_sizes, int n_in, void* d_out, int out_size, void* d_ws, size_t ws_size, hipStream_t stream) {
    static int grid = 0;
    if (grid == 0) {
        if (n_in != 12 || in_sizes[0] != MTOK * DM || out_size != MTOK * DM || ws_size < WS_END) { fprintf(stderr, "kernel_launch: unexpected shapes / workspace (n_in %d, in0 %d, out %d, ws %zu)\n", n_in, n_in > 0 ? in_sizes[0] : -1, out_size, ws_size); grid = -1; return; }
        int dev = 0, cus = 0, per_cu = 0;
        hipGetDevice(&dev); hipDeviceGetAttribute(&cus, hipDeviceAttributeMultiprocessorCount, dev);
        if (hipFuncSetAttribute((const void*)fwd_megakernel, hipFuncAttributeMaxDynamicSharedMemorySize, LDS_BYTES) != hipSuccess) { fprintf(stderr, "kernel_launch: hipFuncSetAttribute failed\n"); grid = -1; return; }
        if (hipOccupancyMaxActiveBlocksPerMultiprocessor(&per_cu, (const void*)fwd_megakernel, NWAVES * 64, LDS_BYTES) != hipSuccess || per_cu < 1) { fprintf(stderr, "kernel_launch: occupancy query says %d\n", per_cu); per_cu = 1; }
        (void)hipGetLastError();
        grid = cus * per_cu;
    }
    if (grid < 0) return;
    Args a{};
    for (int i = 0; i < 12; ++i) a.in[i] = (const float*)d_in[i];
    a.out = (float*)d_out; a.ws = (unsigned char*)d_ws;
    void* kargs[] = {&a};
    hipError_t e = hipLaunchCooperativeKernel((const void*)fwd_megakernel, dim3(grid), dim3(NWAVES * 64), kargs, LDS_BYTES, stream);
    if (e != hipSuccess) fprintf(stderr, "kernel_launch: cooperative launch failed: %s (grid %d)\n", hipGetErrorString(e), grid);
}
```

```cpp
#include <hip/hip_runtime.h>
#include <hip/hip_cooperative_groups.h>
#include <cstdio>
#include <cstdint>
namespace cg = cooperative_groups;
namespace pg8 {
#define PG8_LAS __attribute__((address_space(3)))
typedef unsigned short bf16_t;
typedef short bf16x8 __attribute__((ext_vector_type(8)));
typedef float f32x4 __attribute__((ext_vector_type(4)));
typedef unsigned u32x4 __attribute__((ext_vector_type(4)));
constexpr int BM = 256, BK = 64, HALF = 128, HTB = HALF * BK * 2  , STAGE_BYTES = 8 * HTB, NXCD = 8, WGM = 8;

__host__ __device__ __forceinline__ int lds_byte(int r, int c) { const int st = (r >> 4) * 2 + (c >> 5), rr = r & 15, cc = c & 31, ob = rr * 64 + cc * 2; return st * 1024 + (ob ^ (((ob >> 9) & 1) << 5)); }
__host__ __device__ __forceinline__ void stage_rc(int b, int& R, int& C) { const int st = b / 1024, sb = b % 1024, swz = sb ^ (((sb >> 9) & 1) << 5); R = (st >> 1) * 16 + swz / 64; C = (st & 1) * 32 + (swz % 64) / 2; }
__host__ __device__ __forceinline__ int perm32(int rho) { const int n = rho >> 4, i = rho & 15; return 8 * (i >> 2) + 4 * n + (i & 3); }

typedef unsigned u32x2 __attribute__((ext_vector_type(2)));
struct Unit { int pm, pn, w; };
struct Gemm { const bf16_t* A; const bf16_t* Bt; int M, N, K; const bf16_t* A2; const bf16_t* Bt2; };

struct StaticOrder {
    int nM, nN, nwg, G, c, n2;
    __host__ __device__ void init(int M, int N, int G_, int c_, int n2_ = 0) { nM = M / BM; nN = N / BM; nwg = nM * nN; G = G_; c = c_; n2 = n2_; }
    __host__ __device__ bool next(int i, Unit& u) const {
        const long L = (long)i * G + c; if (L >= nwg + n2) return false;
        if (L >= nwg) { u.w = 1; u.pm = 0; u.pn = (int)(L - nwg); return true; }
        u.w = 0;
        int wgid = (int)L; { const int q = nwg / NXCD, r = nwg % NXCD, xcd = wgid % NXCD, off = wgid / NXCD; wgid = (xcd < r ? xcd * (q + 1) : r * (q + 1) + (xcd - r) * q) + off; }
        const int nig = WGM * nN, gid = wgid / nig, fm = gid * WGM, gsz = (nM - fm) < WGM ? (nM - fm) : WGM;
        u.pm = fm + ((wgid % nig) % gsz); u.pn = (wgid % nig) / gsz; return true;
    }
    __device__ __forceinline__ void a_ready(const Unit&) const {}
    __device__ __forceinline__ void done(const Unit&) const {}
};

typedef float f32x2_t __attribute__((ext_vector_type(2))); typedef __bf16 bf16x2_t __attribute__((ext_vector_type(2)));
__device__ __forceinline__ unsigned cvt_pk_bf16(float lo, float hi) { const f32x2_t v = {lo, hi}; const bf16x2_t b = __builtin_convertvector(v, bf16x2_t); return __builtin_bit_cast(unsigned, b); }
__device__ __forceinline__ u32x4 pack8(const f32x4 a, const f32x4 b) { u32x4 w; w.x = cvt_pk_bf16(a[0], a[1]); w.y = cvt_pk_bf16(a[2], a[3]); w.z = cvt_pk_bf16(b[0], b[1]); w.w = cvt_pk_bf16(b[2], b[3]); return w; }
__device__ __forceinline__ f32x4 bf_lo4(const u32x4 w) { return (f32x4){__uint_as_float(w.x << 16), __uint_as_float(w.x & 0xffff0000u), __uint_as_float(w.y << 16), __uint_as_float(w.y & 0xffff0000u)}; }
__device__ __forceinline__ f32x4 bf_hi4(const u32x4 w) { return (f32x4){__uint_as_float(w.z << 16), __uint_as_float(w.z & 0xffff0000u), __uint_as_float(w.w << 16), __uint_as_float(w.w & 0xffff0000u)}; }

struct EpiStore {
    static constexpr bool PERM = true, AFTER_DRAIN = false;
    bf16_t* O; int ldc;
    __device__ __forceinline__ void operator()(const f32x4 (&acc)[2][2][4][2], const Unit& u, int wr, int wc, int fr, int fq) const {
        const int row0 = u.pm * BM + wr * 64 + fr, col0 = u.pn * BM + wc * 32 + 8 * fq;
#pragma unroll
        for (int ai = 0; ai < 2; ++ai)
#pragma unroll
            for (int m = 0; m < 4; ++m) { bf16_t* rowp = O + (size_t)(row0 + ai * HALF + m * 16) * ldc + col0;
#pragma unroll
                for (int bj = 0; bj < 2; ++bj) *(u32x4*)(rowp + bj * HALF) = pack8(acc[ai][bj][m][0], acc[ai][bj][m][1]); }
    }
};

struct EpiQKV {
    static constexpr bool PERM = true, AFTER_DRAIN = false;
    bf16_t* Q; long offK, offV; const float* rcos; const float* rsin; const float* rs; float qscale; int mtok;
    __device__ __forceinline__ void operator()(const f32x4 (&acc)[2][2][4][2], const Unit& u, int wr, int wc, int fr, int fq) const {
        const bool isv = u.w != 0, isq = u.pn < 4;
        bf16_t* base = Q + (isv ? offV : (isq ? 0L : offK)); const int ldc = isv ? mtok : (isq ? 1024 : 256), colt = (isv || isq) ? u.pn * BM : 0; const float sc = (!isv && isq) ? qscale : 1.0f;
        const int i0 = 4 * ((wc & 1) * 4 + fq);
#pragma unroll
        for (int ai = 0; ai < 2; ++ai)
#pragma unroll
            for (int m = 0; m < 4; ++m) {
                const int row = u.pm * BM + ai * HALF + wr * 64 + m * 16 + fr, s = row & 2047;
                f32x4 c = (f32x4){1.f, 1.f, 1.f, 1.f}, sn = (f32x4){0.f, 0.f, 0.f, 0.f};
                if (!isv) { const float rr = rs[row] * sc; c = *(const f32x4*)(rcos + s * 32 + i0) * rr; sn = *(const f32x4*)(rsin + s * 32 + i0) * rr; }
                bf16_t* rowp = base + (size_t)row * ldc + colt + wc * 32 + 8 * fq;
#pragma unroll
                for (int bj = 0; bj < 2; ++bj) { f32x4 x1 = acc[ai][bj][m][0], x2 = acc[ai][bj][m][1];
                    if (isv) { const float* rp = rs + u.pn * BM + bj * HALF + wc * 32 + 8 * fq; x1 = x1 * *(const f32x4*)rp; x2 = x2 * *(const f32x4*)(rp + 4); }
                    *(u32x4*)(rowp + bj * HALF) = pack8(x1 * c - x2 * sn, x2 * c + x1 * sn); }
                if (m & 1) asm volatile("" ::: "memory");
            }
    }
};

struct EpiCX {
    static constexpr bool PERM = true, AFTER_DRAIN = false;
    bf16_t* P; const float* rs;
    __device__ __forceinline__ void operator()(const f32x4 (&acc)[2][2][4][2], const Unit& u, int wr, int wc, int fr, int fq) const {
        const int row0 = u.pm * BM + wr * 64 + fr, col0 = u.pn * HALF + wc * 32 + 8 * fq;
#pragma unroll
        for (int ai = 0; ai < 2; ++ai)
#pragma unroll
            for (int m = 0; m < 4; ++m) { const int row = row0 + ai * HALF + m * 16; const float r1 = rs[row], r2 = r1 * r1;
                *(u32x4*)(P + (size_t)row * 1024 + col0) = pack8(acc[ai][0][m][0] * acc[ai][1][m][0] * r2, acc[ai][0][m][1] * acc[ai][1][m][1] * r2); }
    }
};

template <int MODE> struct EpiConv {
    static constexpr bool PERM = true, AFTER_DRAIN = false;
    const bf16_t* G; const float* cw; bf16_t* O; int ldc; const float* rs;
    __device__ __forceinline__ void operator()(const f32x4 (&acc)[2][2][4][2], const Unit& u, int wr, int wc, int fr, int fq) const {
        const int row0 = u.pm * BM + wr * 64 + fr;
#pragma unroll
        for (int bj = 0; bj < 2; ++bj) {
            const int col = u.pn * BM + bj * HALF + wc * 32 + 8 * fq;
            const f32x4 w0a = *(const f32x4*)(cw + col), w0b = *(const f32x4*)(cw + col + 4);
            const f32x4 w1a = *(const f32x4*)(cw + ldc + col), w1b = *(const f32x4*)(cw + ldc + col + 4);
            const f32x4 w2a = *(const f32x4*)(cw + 2 * ldc + col), w2b = *(const f32x4*)(cw + 2 * ldc + col + 4);
#pragma unroll
            for (int ai = 0; ai < 2; ++ai)
#pragma unroll
                for (int m = 0; m < 4; ++m) {
                    const int row = row0 + ai * HALF + m * 16, s = row & 2047; const float rr = rs[row];
                    const bf16_t* gp = G + (size_t)row * ldc + col;
                    const u32x4 zc = *(const u32x4*)gp;
                    u32x4 zp = (u32x4){0u, 0u, 0u, 0u}, zn = (u32x4){0u, 0u, 0u, 0u};
                    if (s > 0) zp = *(const u32x4*)(gp - ldc);
                    if (s < 2047) zn = *(const u32x4*)(gp + ldc);
                    f32x4 za = w0a * bf_lo4(zp) + w1a * bf_lo4(zc) + w2a * bf_lo4(zn);
                    f32x4 zb = w0b * bf_hi4(zp) + w1b * bf_hi4(zc) + w2b * bf_hi4(zn);
                    f32x4 oa, ob;
                    if (MODE == 0) { oa = acc[ai][bj][m][0] * za * rr; ob = acc[ai][bj][m][1] * zb * rr; }
                    else {
#pragma unroll
                        for (int e = 0; e < 4; ++e) {
                            oa[e] = za[e] * __builtin_amdgcn_rcpf(1.0f + __builtin_amdgcn_exp2f(za[e] * -1.4426950408889634f)) * acc[ai][bj][m][0][e];
                            ob[e] = zb[e] * __builtin_amdgcn_rcpf(1.0f + __builtin_amdgcn_exp2f(zb[e] * -1.4426950408889634f)) * acc[ai][bj][m][1][e]; }
                    }
                    *(u32x4*)(O + (size_t)row * ldc + col) = pack8(oa, ob);
                    if (m & 1) asm volatile("" ::: "memory");
                }
        }
    }
};

__device__ __forceinline__ float dpp_shr1(float oldv, float src) { return __int_as_float(__builtin_amdgcn_update_dpp(__float_as_int(oldv), __float_as_int(src), 0x111, 0xf, 0xf, false)); }
__device__ __forceinline__ float dpp_shl1(float oldv, float src) { return __int_as_float(__builtin_amdgcn_update_dpp(__float_as_int(oldv), __float_as_int(src), 0x101, 0xf, 0xf, false)); }
__device__ __forceinline__ float dpp_ror1(float src) { return __int_as_float(__builtin_amdgcn_update_dpp(0, __float_as_int(src), 0x121, 0xf, 0xf, false)); }
__device__ __forceinline__ float dpp_ror15(float src) { return __int_as_float(__builtin_amdgcn_update_dpp(0, __float_as_int(src), 0x12F, 0xf, 0xf, false)); }
struct EpiGU {
    static constexpr bool PERM = true, AFTER_DRAIN = false;
    float* EDGE; const float* cw; bf16_t* ACT; PG8_LAS unsigned char* xlds; int ff; const float* rs;
    __device__ __forceinline__ void operator()(f32x4 (&acc)[2][2][4][2], const Unit& u, int wr, int wc, int fr, int fq) const {
        const int colg = 32 * wc + 8 * fq, ch0 = u.pn * HALF + colg, pmod = u.pm & 7;
        { float rr[2][4];
#pragma unroll
            for (int ai = 0; ai < 2; ++ai)
#pragma unroll
                for (int m = 0; m < 4; ++m) rr[ai][m] = rs[u.pm * BM + ai * HALF + wr * 64 + m * 16 + fr];
#pragma unroll
            for (int ai = 0; ai < 2; ++ai)
#pragma unroll
                for (int m = 0; m < 4; ++m)
#pragma unroll
                    for (int bj = 0; bj < 2; ++bj)
#pragma unroll
                        for (int n = 0; n < 2; ++n) acc[ai][bj][m][n] = acc[ai][bj][m][n] * rr[ai][m]; }
        PG8_LAS float* XF = (PG8_LAS float*)xlds; PG8_LAS float* XL = XF + 4 * HALF;
        if (fr == 0) {
#pragma unroll
            for (int ai = 0; ai < 2; ++ai)
#pragma unroll
                for (int n = 0; n < 2; ++n) *(PG8_LAS f32x4*)(XF + (2 * ai + wr) * HALF + colg + 4 * n) = acc[ai][0][0][n];
        }
        if (fr == 15) {
#pragma unroll
            for (int ai = 0; ai < 2; ++ai)
#pragma unroll
                for (int n = 0; n < 2; ++n) *(PG8_LAS f32x4*)(XL + (2 * ai + wr) * HALF + colg + 4 * n) = acc[ai][0][3][n];
        }
        asm volatile("s_waitcnt lgkmcnt(0)" ::: "memory"); __builtin_amdgcn_s_barrier(); asm volatile("" ::: "memory");
#pragma unroll
        for (int ai = 0; ai < 2; ++ai) {
            const int k = 2 * ai + wr;
            f32x4 pr[2], nx[2];
#pragma unroll
            for (int n = 0; n < 2; ++n) {
                pr[n] = (k == 0) ? (f32x4){0.f, 0.f, 0.f, 0.f} : *(const PG8_LAS f32x4*)(XL + ((k + 3) & 3) * HALF + colg + 4 * n);
                nx[n] = (k == 3) ? (f32x4){0.f, 0.f, 0.f, 0.f} : *(const PG8_LAS f32x4*)(XF + ((k + 1) & 3) * HALF + colg + 4 * n);
            }
#pragma unroll
            for (int n = 0; n < 2; ++n) {
                const f32x4 w0 = *(const f32x4*)(cw + ch0 + 4 * n), w1 = *(const f32x4*)(cw + ff + ch0 + 4 * n), w2 = *(const f32x4*)(cw + 2 * ff + ch0 + 4 * n);
#pragma unroll
                for (int m = 0; m < 4; ++m) {
                    f32x4 o, zz;
#pragma unroll
                    for (int e = 0; e < 4; ++e) {
                        const float g = acc[ai][0][m][n][e];
                        const float oldp = (m == 0) ? pr[n][e] : dpp_ror1(acc[ai][0][m > 0 ? m - 1 : 0][n][e]);
                        const float oldn = (m == 3) ? nx[n][e] : dpp_ror15(acc[ai][0][m < 3 ? m + 1 : 3][n][e]);
                        const float P = dpp_shr1(oldp, g), N = dpp_shl1(oldn, g);
                        const float z = w0[e] * P + w1[e] * g + w2[e] * N; zz[e] = z;
                        o[e] = z * __builtin_amdgcn_rcpf(1.0f + __builtin_amdgcn_exp2f(z * -1.4426950408889634f)) * acc[ai][1][m][n][e];
                    }
                    if ((k == 0 && m == 0 && fr == 0) || (k == 3 && m == 3 && fr == 15)) {
                        float* ep = EDGE + ((size_t)(u.pm * 2 + (k == 3 ? 1 : 0)) * 3) * ff + ch0 + 4 * n;
                        *(f32x4*)ep = zz; *(f32x4*)(ep + ff) = acc[ai][1][m][n]; *(f32x4*)(ep + 2 * ff) = acc[ai][0][m][n]; }
                    u32x2 w; w.x = cvt_pk_bf16(o[0], o[1]); w.y = cvt_pk_bf16(o[2], o[3]);
                    *(u32x2*)(ACT + (size_t)(u.pm * BM + ai * HALF + wr * 64 + m * 16 + fr) * ff + ch0 + 4 * n) = w;
                }
            }
        }
    }
};

template <class Epi, class Sched, bool ALIGN_EPI = false, bool SP2 = false>
__device__ __forceinline__ void gemm_phase(PG8_LAS unsigned char* lds, const Gemm g, const Sched& S, const Epi& E) {
    int tid_ = threadIdx.x; asm volatile("" : "+v"(tid_));
    const int tid = tid_, wid = __builtin_amdgcn_readfirstlane(tid >> 6), lane = tid & 63, wr = wid >> 2, wc = wid & 3, fr = lane & 15, fq = lane >> 4;
    const int K = g.K, nt = K / BK;
    unsigned voffA[2], voffB[2];
#pragma unroll
    for (int i = 0; i < 2; ++i) { int R, C; stage_rc(tid * 16 + i * 8192, R, C); const int Rb = Epi::PERM ? ((R & ~31) + perm32(R & 31)) : R;
        voffA[i] = (unsigned)(R * K + C) * 2u; voffB[i] = (unsigned)(Rb * K + C) * 2u; }
    const size_t kstep = (size_t)(BK * 2);
    const size_t hstep = (size_t)HALF * K * 2;
    const size_t tstep = 2 * hstep;
    const unsigned ldsw = (unsigned)wid * 1024u;
    const int aoff = lds_byte(wr * 64 + fr, fq * 8), boff = lds_byte(wc * 32 + fr, fq * 8);
#define PG8_SA(b, h) (((b) * 2 + (h)) * HTB)
#define PG8_SB(b, h) ((4 + (b) * 2 + (h)) * HTB)
#define PG8_STAGE(bufoff, gbase, voff) do { _Pragma("unroll") for (int _i = 0; _i < 2; ++_i) \
        __builtin_amdgcn_global_load_lds((const unsigned*)((const char*)(gbase) + (voff)[_i]), (PG8_LAS unsigned*)(lds + (bufoff) + ldsw + _i * 8192), 16, 0, 0); } while (0)
#define PG8_LDA(dst, b, h) do { _Pragma("unroll") for (int m = 0; m < 4; ++m) _Pragma("unroll") for (int k = 0; k < 2; ++k) dst[m][k] = *(const PG8_LAS bf16x8*)(lds + PG8_SA(b, h) + aoff + m * 2048 + k * 1024); } while (0)
#define PG8_LDB(dst, b, h) do { _Pragma("unroll") for (int n = 0; n < 2; ++n) _Pragma("unroll") for (int k = 0; k < 2; ++k) dst[n][k] = *(const PG8_LAS bf16x8*)(lds + PG8_SB(b, h) + boff + n * 2048 + k * 1024); } while (0)
#define PG8_MMA(ai, bj, At, Bt) do { __builtin_amdgcn_s_setprio(1); _Pragma("unroll") for (int m = 0; m < 4; ++m) _Pragma("unroll") for (int n = 0; n < 2; ++n) _Pragma("unroll") for (int k = 0; k < 2; ++k) \
        acc[ai][bj][m][n] = __builtin_amdgcn_mfma_f32_16x16x32_bf16(Bt[n][k], At[m][k], acc[ai][bj][m][n], 0, 0, 0); __builtin_amdgcn_s_setprio(0); } while (0)
#define PG8_WAIT_V(n) asm volatile("s_waitcnt vmcnt(" #n ")" ::: "memory")
#define PG8_WAIT_L(n) asm volatile("s_waitcnt lgkmcnt(" #n ")" ::: "memory")
#define PG8_BAR __builtin_amdgcn_s_barrier()
#define PG8_SCHED __builtin_amdgcn_sched_barrier(0)
    Unit cur, nxt; int ui = 0;
    if (!S.next(0, cur)) return;
    f32x4 acc[2][2][4][2];
#pragma unroll
    for (int a = 0; a < 2; ++a)
#pragma unroll
        for (int b = 0; b < 2; ++b)
#pragma unroll
            for (int m = 0; m < 4; ++m)
#pragma unroll
                for (int n = 0; n < 2; ++n) acc[a][b][m][n] = (f32x4){0.f, 0.f, 0.f, 0.f};
    bf16x8 At[4][2], B0[2][2], B1[2][2];
    const char* cA = (const char*)(cur.w ? g.A2 : g.A) + (size_t)cur.pm * tstep; const char* cB = (const char*)(cur.w ? g.Bt2 : g.Bt) + (size_t)cur.pn * tstep;
    S.a_ready(cur);
    if constexpr (SP2) {
        PG8_STAGE(PG8_SB(0, 0), cB, voffB); PG8_STAGE(PG8_SB(0, 1), cB + hstep, voffB); PG8_STAGE(PG8_SA(0, 0), cA, voffA); PG8_STAGE(PG8_SA(0, 1), cA + hstep, voffA);
        if (wr == 1) PG8_BAR;
        PG8_WAIT_V(2); PG8_BAR;
        PG8_STAGE(PG8_SB(1, 0), cB + kstep, voffB); PG8_STAGE(PG8_SA(1, 0), cA + kstep, voffA); PG8_STAGE(PG8_SB(1, 1), cB + hstep + kstep, voffB);
        PG8_WAIT_V(6); PG8_BAR;
    } else {
        PG8_STAGE(PG8_SB(0, 0), cB, voffB); PG8_STAGE(PG8_SA(0, 0), cA, voffA); PG8_STAGE(PG8_SB(0, 1), cB + hstep, voffB); PG8_STAGE(PG8_SA(0, 1), cA + hstep, voffA);
        if (wr == 1) PG8_BAR;
        PG8_WAIT_V(4); PG8_BAR;
        PG8_STAGE(PG8_SB(1, 0), cB + kstep, voffB); PG8_STAGE(PG8_SA(1, 0), cA + kstep, voffA); PG8_STAGE(PG8_SB(1, 1), cB + hstep + kstep, voffB);
        PG8_WAIT_V(6); PG8_BAR;
    }
    for (;;) {
        const bool has_next = S.next(ui + 1, nxt);
        const char* nA = has_next ? (const char*)(nxt.w ? g.A2 : g.A) + (size_t)nxt.pm * tstep : cA; const char* nB = has_next ? (const char*)(nxt.w ? g.Bt2 : g.Bt) + (size_t)nxt.pn * tstep : cB;
        for (int t = 0; t < nt; t += 2) {
            const bool last = (t == nt - 2);
            const char* a1 = cA + (size_t)(t + 1) * kstep;
            const char* a2 = last ? nA : cA + (size_t)(t + 2) * kstep; const char* b2 = last ? nB : cB + (size_t)(t + 2) * kstep;
            const char* a3 = a2 + kstep; const char* b3 = b2 + kstep;
            if (last && has_next) S.a_ready(nxt);
            if constexpr (SP2) {
            PG8_LDB(B0, 0, 0); PG8_LDB(B1, 0, 1); PG8_SCHED; PG8_LDA(At, 0, 0); PG8_STAGE(PG8_SA(1, 1), a1 + hstep, voffA);
            PG8_WAIT_V(8); PG8_WAIT_L(0); PG8_BAR; PG8_MMA(0, 0, At, B0); PG8_MMA(0, 1, At, B1); PG8_BAR; PG8_SCHED;
            PG8_LDA(At, 0, 1); PG8_STAGE(PG8_SB(0, 0), b2, voffB); PG8_STAGE(PG8_SB(0, 1), b2 + hstep, voffB); PG8_STAGE(PG8_SA(0, 0), a2, voffA);
            PG8_WAIT_V(8); PG8_WAIT_L(0); PG8_BAR; PG8_MMA(1, 0, At, B0); PG8_MMA(1, 1, At, B1); PG8_BAR; PG8_SCHED;
            PG8_LDB(B0, 1, 0); PG8_LDB(B1, 1, 1); PG8_SCHED; PG8_LDA(At, 1, 0); PG8_STAGE(PG8_SA(0, 1), a2 + hstep, voffA);
            PG8_WAIT_V(8); PG8_WAIT_L(0); PG8_BAR; PG8_MMA(0, 0, At, B0); PG8_MMA(0, 1, At, B1); PG8_BAR; PG8_SCHED;
            PG8_LDA(At, 1, 1); PG8_STAGE(PG8_SB(1, 0), b3, voffB); PG8_STAGE(PG8_SB(1, 1), b3 + hstep, voffB); PG8_STAGE(PG8_SA(1, 0), a3, voffA);
            PG8_WAIT_V(8); PG8_WAIT_L(0); PG8_BAR; PG8_MMA(1, 0, At, B0); PG8_MMA(1, 1, At, B1); PG8_BAR; PG8_SCHED;
            } else {
            PG8_LDB(B0, 0, 0); PG8_SCHED; PG8_LDA(At, 0, 0); PG8_STAGE(PG8_SA(1, 1), a1 + hstep, voffA);
            PG8_WAIT_L(8); PG8_BAR; PG8_WAIT_L(0); PG8_MMA(0, 0, At, B0); PG8_BAR; PG8_SCHED;
            PG8_LDB(B1, 0, 1); PG8_STAGE(PG8_SB(0, 0), b2, voffB);
            PG8_BAR; PG8_WAIT_L(0); PG8_MMA(0, 1, At, B1); PG8_BAR;
            PG8_LDA(At, 0, 1); PG8_STAGE(PG8_SA(0, 0), a2, voffA);
            PG8_BAR; PG8_WAIT_L(0); PG8_MMA(1, 0, At, B0); PG8_BAR; PG8_SCHED;
            PG8_STAGE(PG8_SB(0, 1), b2 + hstep, voffB);
            PG8_WAIT_V(6); PG8_BAR; PG8_MMA(1, 1, At, B1); PG8_BAR;
            PG8_LDB(B0, 1, 0); PG8_SCHED; PG8_LDA(At, 1, 0); PG8_STAGE(PG8_SA(0, 1), a2 + hstep, voffA);
            PG8_WAIT_L(8); PG8_BAR; PG8_WAIT_L(0); PG8_MMA(0, 0, At, B0); PG8_BAR; PG8_SCHED;
            PG8_LDB(B1, 1, 1); PG8_STAGE(PG8_SB(1, 0), b3, voffB);
            PG8_BAR; PG8_WAIT_L(0); PG8_MMA(0, 1, At, B1); PG8_BAR;
            PG8_LDA(At, 1, 1); PG8_STAGE(PG8_SA(1, 0), a3, voffA);
            PG8_BAR; PG8_WAIT_L(0); PG8_MMA(1, 0, At, B0); PG8_BAR; PG8_SCHED;
            PG8_STAGE(PG8_SB(1, 1), b3 + hstep, voffB);
            PG8_WAIT_V(6); PG8_BAR; PG8_MMA(1, 1, At, B1); PG8_BAR;
            }
        }
        if constexpr (ALIGN_EPI) { if (wr == 0) PG8_BAR; }
        if constexpr (!Epi::AFTER_DRAIN) { E(acc, cur, wr, wc, fr, fq); S.done(cur); }
        if (!has_next) break;
#pragma unroll
        for (int a = 0; a < 2; ++a)
#pragma unroll
            for (int b = 0; b < 2; ++b)
#pragma unroll
                for (int m = 0; m < 4; ++m)
#pragma unroll
                    for (int n = 0; n < 2; ++n) acc[a][b][m][n] = (f32x4){0.f, 0.f, 0.f, 0.f};
        cur = nxt; cA = nA; cB = nB; ++ui;
        if constexpr (ALIGN_EPI) { if (wr == 1) PG8_BAR; }
    }
    PG8_WAIT_V(0);
    if constexpr (!ALIGN_EPI) { if (wr == 0) PG8_BAR; }
    PG8_BAR;
    if constexpr (Epi::AFTER_DRAIN) { E.fused(acc, cur, wr, wc, fr, fq, lds, wid, lane); S.done(cur); }
#undef PG8_SA
#undef PG8_SB
#undef PG8_STAGE
#undef PG8_LDA
#undef PG8_LDB
#undef PG8_MMA
#undef PG8_WAIT_V
#undef PG8_WAIT_L
#undef PG8_BAR
#undef PG8_SCHED
}
}

constexpr int BATCH = 16, SEQ = 2048, DM = 1024, MTOK = BATCH * SEQ, NQKV = 1536, FF = 2816, NH = 16, NKV = 4, HD = 64;
constexpr float RMS_EPS = 1e-6f, LOG2E = 1.4426950408889634f;
constexpr int NWAVES = 8;
#define LAS __attribute__((address_space(3)))
typedef unsigned short bf16;
typedef float f32x4 __attribute__((ext_vector_type(4)));
typedef float f32x16 __attribute__((ext_vector_type(16)));
typedef unsigned u32x4 __attribute__((ext_vector_type(4)));
typedef unsigned u32x2 __attribute__((ext_vector_type(2)));
typedef short bf16x8 __attribute__((ext_vector_type(8)));

constexpr size_t MiB = 1u << 20;
constexpr size_t WS_WQKV = 0, WS_WO = 3 * MiB, WS_WIN = 5 * MiB, WS_WOUT = 11 * MiB, WS_WGU = 13 * MiB  , WS_WD = 35 * MiB  ;
constexpr size_t WS_ROPE = 46 * MiB;
constexpr size_t WS_CTL = 46 * MiB + 768 * 1024;
constexpr size_t WS_RS = 46 * MiB + 832 * 1024;
constexpr size_t WS_EDGE = 47 * MiB;
constexpr size_t WS_XN = 56 * MiB;
constexpr size_t WS_Y = 120 * MiB;
constexpr size_t WS_ACT = 184 * MiB;
constexpr size_t WS_Q = 184 * MiB, WS_K = 248 * MiB, WS_VT = 264 * MiB;
constexpr size_t WS_P = 184 * MiB, WS_Y2 = 248 * MiB;
constexpr size_t WS_END = 360 * MiB;

constexpr int LDS_BYTES = 147456, LDS_BARST = 131072 + 64, LDS_XCH = 131072 + 1024;
constexpr int BAR_WORDS = 3456;

__device__ __forceinline__ unsigned f2bf(float f) { unsigned u = __builtin_bit_cast(unsigned, f); return (u + 0x7fffu + ((u >> 16) & 1u)) >> 16; }
__device__ __forceinline__ unsigned pk2(float lo, float hi) { return f2bf(lo) | (f2bf(hi) << 16); }
__device__ __forceinline__ float wave_sum(float v) {
#pragma unroll
    for (int o = 1; o < 64; o <<= 1) v += __shfl_xor(v, o);
    return v;
}

#define RLX_AGENT __ATOMIC_RELAXED, __HIP_MEMORY_SCOPE_AGENT
#define XB_TMO      128
#define XB_XCNT(j)  (256  + 64 * (j))
#define XB_XSUB(j)  (1280 + 64 * (j))
#define XB_XGEN(j)  (2304 + 64 * (j))
#define XB_TOP      3328
#define XB_TOPGEN   3392
#define XCD_BAR_WORDS 3456
#define XB_SPIN_CAP (1u << 18)

__device__ __forceinline__ unsigned xb_ld(unsigned* p)              { return __hip_atomic_load(p, __ATOMIC_RELAXED, __HIP_MEMORY_SCOPE_AGENT); }
__device__ __forceinline__ unsigned xb_add(unsigned* p, unsigned v) { return __hip_atomic_fetch_add(p, v, __ATOMIC_RELAXED, __HIP_MEMORY_SCOPE_AGENT); }
__device__ __forceinline__ unsigned xb_xcc_id() { return (unsigned)__builtin_amdgcn_s_getreg((3 << 11) | 20) & 0xFu; }
#define XB_SPIN(cond, bar) do { unsigned _sp = 0; while (cond) { __builtin_amdgcn_s_sleep(1); \
    if ((++_sp & 255u) == 0u) { if (xb_ld(&(bar)[XB_TMO])) break; if (_sp > XB_SPIN_CAP) { atomicAdd(&(bar)[XB_TMO], 1u); break; } } } } while (0)

struct XcdBarrier {
    unsigned* bar; unsigned x;
    volatile LAS unsigned* st;
};

__device__ __forceinline__ XcdBarrier xcd_barrier_post(unsigned* bar, volatile LAS unsigned* st) {
    XcdBarrier b; b.bar = bar; b.x = xb_xcc_id(); b.st = st;
    if (threadIdx.x == 0) (void)xb_add(&bar[XB_XCNT(b.x)], 1u);
    return b;
}
__device__ __forceinline__ void xcd_barrier_complete(unsigned* bar, unsigned x, unsigned& nloc, unsigned& nx) {
    const unsigned G = gridDim.x * gridDim.y * gridDim.z;
    unsigned sum, cnt, mine, sp = 0u;
    for (;;) {
        sum = 0u; cnt = 0u; mine = 0u;
#pragma unroll
        for (unsigned j = 0; j < 16; ++j) { const unsigned c = xb_ld(&bar[XB_XCNT(j)]); sum += c; cnt += (c > 0u) ? 1u : 0u; mine = (j == x) ? c : mine; }
        if (sum == G) break;
        __builtin_amdgcn_s_sleep(1);
        if ((++sp & 255u) == 0u) { if (xb_ld(&bar[XB_TMO])) break; if (sp > XB_SPIN_CAP) { atomicAdd(&bar[XB_TMO], 1u); break; } }
    }
    nloc = mine > 0u ? mine : 1u; nx = cnt > 0u ? cnt : 1u;
}

__device__ __forceinline__ void xcd_barrier(const XcdBarrier& b) {
    asm volatile("s_waitcnt vmcnt(0)" ::: "memory");
    __syncthreads();
    if (threadIdx.x == 0) {
        unsigned* bar = b.bar;
        __builtin_amdgcn_s_waitcnt(0);
        unsigned nloc = b.st[0], nx = b.st[1];
        if (nloc == 0u) { xcd_barrier_complete(bar, b.x, nloc, nx); b.st[0] = nloc; b.st[1] = nx; }
        const unsigned old = xb_add(&bar[XB_XSUB(b.x)], 1u);
        const unsigned gen = old / nloc;
        if (old + 1u == (gen + 1u) * nloc) {
            __builtin_amdgcn_fence(__ATOMIC_RELEASE, "agent");
            asm volatile("s_waitcnt vmcnt(0)" ::: "memory");
            const unsigned og = xb_add(&bar[XB_TOP], 1u);
            const unsigned tg = og / nx;
            if (og + 1u == (tg + 1u) * nx) xb_add(&bar[XB_TOPGEN], 1u);
            else XB_SPIN(xb_ld(&bar[XB_TOPGEN]) == tg, bar);
            __builtin_amdgcn_fence(__ATOMIC_ACQUIRE, "agent");
            xb_add(&bar[XB_XGEN(b.x)], 1u);
            asm volatile("s_waitcnt vmcnt(0)" ::: "memory");
        } else {
            XB_SPIN(xb_ld(&bar[XB_XGEN(b.x)]) == gen, bar);
            __builtin_amdgcn_fence(__ATOMIC_ACQUIRE, "agent");
            asm volatile("s_waitcnt vmcnt(0)" ::: "memory");
        }
    }
    __syncthreads();
}

namespace att {
constexpr int KSTR = 144, VSTR = 776, LDS_K = 0, LDS_V = 384 * KSTR;
__device__ __forceinline__ int crow(int r, int hi) { return (r & 3) + 8 * (r >> 2) + 4 * hi; }
#define MFMA32(a, b, c) __builtin_amdgcn_mfma_f32_32x32x16_bf16((a), (b), (c), 0, 0, 0)
__device__ __forceinline__ void attn_phase(LAS unsigned char* lds, const bf16* Q, bf16* O, const bf16* Kg, const bf16* Vt, const float* sink) {
    int tid_ = threadIdx.x; asm volatile("" : "+v"(tid_));
    const int tid = tid_, lane = tid & 63, wid = __builtin_amdgcn_readfirstlane(tid >> 6), i32 = lane & 31, hi = lane >> 5;
    for (int u = blockIdx.x; u < BATCH * 16 * NKV; u += gridDim.x) {
        const int kvh = u & 3, blk = (u >> 2) & 15, b = u >> 6;
        const int tlo = blk == 0 ? 128 : 0, thi = blk == 15 ? 256 : 384;
        const long tok0 = (long)b * SEQ + blk * 128 - 128;
#pragma unroll
        for (int j = 0; j < 6; ++j) { const int id = tid + 512 * j, t = id >> 3, c = id & 7;
            if (t >= tlo && t < thi) { const u32x4 v = *(const u32x4*)(Kg + (tok0 + t) * 256 + kvh * 64 + c * 8); *(LAS u32x4*)(lds + LDS_K + t * KSTR + c * 16) = v; } }
#pragma unroll
        for (int j = 0; j < 6; ++j) { const int id = tid + 512 * j, d = id / 48, ch = id % 48, t = ch * 8;
            if (t >= tlo && t < thi) { const u32x4 v = *(const u32x4*)(Vt + (size_t)(kvh * 64 + d) * MTOK + tok0 + t);
                LAS u32x2* p = (LAS u32x2*)(lds + LDS_V + d * VSTR + ch * 16); p[0] = (u32x2){v.x, v.y}; p[1] = (u32x2){v.z, v.w}; } }
        __syncthreads();
        const int g = wid >> 1, r0 = (wid & 1) * 64, h = kvh * 4 + g;
        const long qrow0 = (long)b * SEQ + blk * 128 + r0;
        bf16x8 qf[2][4];
#pragma unroll
        for (int qt = 0; qt < 2; ++qt)
#pragma unroll
            for (int dc = 0; dc < 4; ++dc) qf[qt][dc] = *(const bf16x8*)(Q + (qrow0 + qt * 32 + i32) * 1024 + h * 64 + dc * 16 + hi * 8);
        f32x16 o[2][2];
#pragma unroll
        for (int a = 0; a < 2; ++a)
#pragma unroll
            for (int c = 0; c < 2; ++c)
#pragma unroll
                for (int r = 0; r < 16; ++r) o[a][c][r] = 0.f;
        const float sink2 = sink[h] * LOG2E;
        float mrun[2] = {sink2, sink2}, lrun[2] = {0.f, 0.f};
        const int ktlo = (tlo > r0 ? tlo : r0) >> 5, kthi = (thi < r0 + 320 ? thi : r0 + 320) >> 5;
        for (int kt = ktlo; kt < kthi; ++kt) {
            const int t0 = kt * 32;
            f32x16 s[2];
#pragma unroll
            for (int r = 0; r < 16; ++r) { s[0][r] = -mrun[0]; s[1][r] = -mrun[1]; }
#pragma unroll
            for (int dc = 0; dc < 4; ++dc) { const bf16x8 kf = *(const LAS bf16x8*)(lds + LDS_K + (t0 + i32) * KSTR + dc * 32 + hi * 16);
                s[0] = MFMA32(kf, qf[0][dc], s[0]); s[1] = MFMA32(kf, qf[1][dc], s[1]); }
            bf16x8 vf[2][2];
#pragma unroll
            for (int dt = 0; dt < 2; ++dt)
#pragma unroll
                for (int c = 0; c < 2; ++c) { const LAS unsigned char* vp = lds + LDS_V + (dt * 32 + i32) * VSTR + (t0 + 16 * c + 4 * hi) * 2;
                    const u32x2 lo = *(const LAS u32x2*)vp, hh = *(const LAS u32x2*)(vp + 16); vf[dt][c] = __builtin_bit_cast(bf16x8, (u32x4){lo.x, lo.y, hh.x, hh.y}); }
            const bool full = (t0 >= r0 + 63) && (t0 + 31 <= r0 + 256);
            if (!full) {
#pragma unroll
                for (int qt = 0; qt < 2; ++qt) { const int rq = r0 + qt * 32 + i32;
#pragma unroll
                    for (int r = 0; r < 16; ++r) { const int t = t0 + crow(r, hi); if (t < rq || t > rq + 256) s[qt][r] = -1e30f; } }
            }
#pragma unroll
            for (int qt = 0; qt < 2; ++qt) {
                float mx = s[qt][0];
#pragma unroll
                for (int r = 1; r < 16; ++r) mx = fmaxf(mx, s[qt][r]);
                mx = fmaxf(mx, __shfl_xor(mx, 32));
                if (__any(mx > 8.0f)) {
                    const float dl = fmaxf(mx, 0.f), alpha = __builtin_amdgcn_exp2f(-dl);
                    mrun[qt] += dl; lrun[qt] *= alpha;
#pragma unroll
                    for (int r = 0; r < 16; ++r) { s[qt][r] -= dl; o[qt][0][r] *= alpha; o[qt][1][r] *= alpha; }
                }
                float ls = 0.f;
#pragma unroll
                for (int r = 0; r < 16; ++r) { const float p = __builtin_amdgcn_exp2f(s[qt][r]); s[qt][r] = p; ls += p; }
                lrun[qt] += ls;
                u32x4 p0, p1;
                p0.x = pg8::cvt_pk_bf16(s[qt][0], s[qt][1]); p0.y = pg8::cvt_pk_bf16(s[qt][2], s[qt][3]); p0.z = pg8::cvt_pk_bf16(s[qt][4], s[qt][5]); p0.w = pg8::cvt_pk_bf16(s[qt][6], s[qt][7]);
                p1.x = pg8::cvt_pk_bf16(s[qt][8], s[qt][9]); p1.y = pg8::cvt_pk_bf16(s[qt][10], s[qt][11]); p1.z = pg8::cvt_pk_bf16(s[qt][12], s[qt][13]); p1.w = pg8::cvt_pk_bf16(s[qt][14], s[qt][15]);
                const bf16x8 pf0 = __builtin_bit_cast(bf16x8, p0), pf1 = __builtin_bit_cast(bf16x8, p1);
#pragma unroll
                for (int dt = 0; dt < 2; ++dt) { o[qt][dt] = MFMA32(vf[dt][0], pf0, o[qt][dt]); o[qt][dt] = MFMA32(vf[dt][1], pf1, o[qt][dt]); }
            }
        }
#pragma unroll
        for (int qt = 0; qt < 2; ++qt) {
            const float lt = lrun[qt] + __shfl_xor(lrun[qt], 32) + __builtin_amdgcn_exp2f(sink2 - mrun[qt]);
            const float inv = 1.0f / lt;
            bf16* orow = O + (qrow0 + qt * 32 + i32) * 1024 + h * 64 + 4 * hi;
#pragma unroll
            for (int dt = 0; dt < 2; ++dt)
#pragma unroll
                for (int r4 = 0; r4 < 4; ++r4) { u32x2 w; w.x = pg8::cvt_pk_bf16(o[qt][dt][4 * r4] * inv, o[qt][dt][4 * r4 + 1] * inv); w.y = pg8::cvt_pk_bf16(o[qt][dt][4 * r4 + 2] * inv, o[qt][dt][4 * r4 + 3] * inv);
                    *(u32x2*)(orow + dt * 32 + 8 * r4) = w; }
        }
        __syncthreads();
    }
}
}

template <bool FIRST, bool LAST>
__device__ __forceinline__ void seam_pass(const float* xin, bf16* hb, const bf16* y, const float* gpost, float* outp, float* rs) {
    int tid_ = threadIdx.x; asm volatile("" : "+v"(tid_)); const int lane = tid_ & 63, wave = __builtin_amdgcn_readfirstlane(tid_ >> 6);
    const int gw = blockIdx.x * NWAVES + wave, NGW = gridDim.x * NWAVES;
    f32x4 g[4];
#pragma unroll
    for (int j = 0; j < 4; ++j) g[j] = *(const f32x4*)(gpost + 4 * lane + 256 * j);
    for (int row0 = 2 * gw; row0 < MTOK; row0 += 2 * NGW) {
        f32x4 yv[2][4], hv[2][4];
#pragma unroll
        for (int q = 0; q < 2; ++q) { const size_t off = (size_t)(row0 + q) * DM + 4 * lane;
#pragma unroll
            for (int j = 0; j < 4; ++j) { const u32x2 w = *(const u32x2*)(y + off + 256 * j);
                yv[q][j] = (f32x4){__uint_as_float(w.x << 16), __uint_as_float(w.x & 0xffff0000u), __uint_as_float(w.y << 16), __uint_as_float(w.y & 0xffff0000u)};
                if (FIRST) hv[q][j] = *(const f32x4*)(xin + off + 256 * j);
                else { const u32x2 hw = *(const u32x2*)(hb + off + 256 * j);
                    hv[q][j] = (f32x4){__uint_as_float(hw.x << 16), __uint_as_float(hw.x & 0xffff0000u), __uint_as_float(hw.y << 16), __uint_as_float(hw.y & 0xffff0000u)}; } } }
#pragma unroll
        for (int q = 0; q < 2; ++q) { const int row = row0 + q; const size_t off = (size_t)row * DM + 4 * lane;
            float ss = 0.f;
#pragma unroll
            for (int j = 0; j < 4; ++j) ss += (yv[q][j][0] * yv[q][j][0] + yv[q][j][1] * yv[q][j][1]) + (yv[q][j][2] * yv[q][j][2] + yv[q][j][3] * yv[q][j][3]);
            const float a = 1.0f / sqrtf(wave_sum(ss) * (1.0f / DM) + RMS_EPS);
            float s2 = 0.f;
#pragma unroll
            for (int j = 0; j < 4; ++j) { const f32x4 hn = hv[q][j] + (yv[q][j] * a) * g[j];
                if (LAST) *(f32x4*)(outp + off + 256 * j) = hn;
                else { u32x2 w; w.x = pk2(hn[0], hn[1]); w.y = pk2(hn[2], hn[3]); *(u32x2*)(hb + off + 256 * j) = w;
                    s2 += (hn[0] * hn[0] + hn[1] * hn[1]) + (hn[2] * hn[2] + hn[3] * hn[3]); } }
            if (!LAST) { const float r2 = 1.0f / sqrtf(wave_sum(s2) * (1.0f / DM) + RMS_EPS); if (lane == 0) rs[row] = r2; }
        }
    }
}
__device__ __forceinline__ void cast_rows(const float* x, bf16* hb, float* rs) {
    int tid_ = threadIdx.x; asm volatile("" : "+v"(tid_)); const int lane = tid_ & 63, wave = __builtin_amdgcn_readfirstlane(tid_ >> 6);
    const int gw = blockIdx.x * NWAVES + wave, NGW = gridDim.x * NWAVES;
    for (int row0 = 2 * gw; row0 < MTOK; row0 += 2 * NGW) {
        f32x4 v[2][4];
#pragma unroll
        for (int q = 0; q < 2; ++q)
#pragma unroll
            for (int j = 0; j < 4; ++j) v[q][j] = *(const f32x4*)(x + (size_t)(row0 + q) * DM + 4 * lane + 256 * j);
#pragma unroll
        for (int q = 0; q < 2; ++q) { const size_t off = (size_t)(row0 + q) * DM + 4 * lane; float ss = 0.f;
#pragma unroll
            for (int j = 0; j < 4; ++j) { ss += (v[q][j][0] * v[q][j][0] + v[q][j][1] * v[q][j][1]) + (v[q][j][2] * v[q][j][2] + v[q][j][3] * v[q][j][3]);
                u32x2 w; w.x = pk2(v[q][j][0], v[q][j][1]); w.y = pk2(v[q][j][2], v[q][j][3]); *(u32x2*)(hb + off + 256 * j) = w; }
            const float r = 1.0f / sqrtf(wave_sum(ss) * (1.0f / DM) + RMS_EPS); if (lane == 0) rs[row0 + q] = r; }
    }
}

__device__ __forceinline__ int map_col(int mode, int n) {
    if (mode == 1) {
        if (n >= 1280) return n;
        const int p = n & 63, j = p >> 3, e = p & 7; return (n & ~63) + (e < 4 ? 4 * j + e : 32 + 4 * j + (e - 4));
    }
    if (mode == 2) {
        if (n >= 2048) return n - 2048;
        const int j = n >> 8, hsel = (n >> 7) & 1, i = n & 127; return 1024 + hsel * 1024 + 128 * j + i;
    }
    if (mode == 3) { const int j = n >> 8, hsel = (n >> 7) & 1, i = n & 127; return hsel * FF + 128 * j + i; }
    return n;
}
__device__ __forceinline__ void transpose_item(const float* W, int K, int N, bf16* WT, int mode, const float* gain, LAS float* scr, int item, int lane) {
    const int nblk = N / 32, kb = item / nblk, nb = item % nblk, k0 = 64 * kb, n0 = 32 * nb;
    const int src = map_col(mode, n0 + (lane & 31));
#pragma unroll 8
    for (int i = 0; i < 32; ++i) { const int kk = 2 * i + (lane >> 5); scr[kk * 33 + (lane & 31)] = W[(size_t)(k0 + kk) * N + src] * (gain ? gain[k0 + kk] : 1.0f); }
    asm volatile("s_waitcnt lgkmcnt(0)" ::: "memory");
    const int c = lane & 7;
#pragma unroll
    for (int j = 0; j < 4; ++j) { const int n = (lane >> 3) + 8 * j; const LAS float* s = scr + (8 * c) * 33 + n;
        u32x4 o; o.x = pk2(s[0 * 33], s[1 * 33]); o.y = pk2(s[2 * 33], s[3 * 33]); o.z = pk2(s[4 * 33], s[5 * 33]); o.w = pk2(s[6 * 33], s[7 * 33]);
        *(u32x4*)(WT + (size_t)(n0 + n) * K + k0 + 8 * c) = o; }
    asm volatile("s_waitcnt lgkmcnt(0)" ::: "memory");
}
__device__ const float INV_FREQ[32] = {1.000000000e+00f, 7.498942614e-01f, 5.623413324e-01f, 4.216965139e-01f, 3.162277639e-01f, 2.371373773e-01f, 1.778279394e-01f, 1.333521307e-01f, 1.000000015e-01f, 7.498941571e-02f, 5.623413250e-02f, 4.216965288e-02f, 3.162277490e-02f, 2.371373773e-02f, 1.778279431e-02f, 1.333521493e-02f, 9.999999776e-03f, 7.498941850e-03f, 5.623413250e-03f, 4.216964822e-03f, 3.162277630e-03f, 2.371373586e-03f, 1.778279431e-03f, 1.333521446e-03f, 1.000000047e-03f, 7.498942432e-04f, 5.623413017e-04f, 4.216965172e-04f, 3.162277571e-04f, 2.371373703e-04f, 1.778279402e-04f, 1.333521504e-04f};
__device__ __forceinline__ void sincos_f64(float angf, float& c, float& s) {
    const double a = (double)angf, k = __builtin_rint(a * 0.63661977236758134308);
    double r = __builtin_fma(-k, 1.57079632679489655800e+00, a); r = __builtin_fma(-k, 6.12323399573676603587e-17, r);
    const double r2 = r * r;
    double sp = -1.0 / 1307674368000.0; sp = sp * r2 + 1.0 / 6227020800.0; sp = sp * r2 - 1.0 / 39916800.0; sp = sp * r2 + 1.0 / 362880.0; sp = sp * r2 - 1.0 / 5040.0; sp = sp * r2 + 1.0 / 120.0; sp = sp * r2 - 1.0 / 6.0; sp = sp * r2 + 1.0;
    double cp = 1.0 / 20922789888000.0; cp = cp * r2 - 1.0 / 87178291200.0; cp = cp * r2 + 1.0 / 479001600.0; cp = cp * r2 - 1.0 / 3628800.0; cp = cp * r2 + 1.0 / 40320.0; cp = cp * r2 - 1.0 / 720.0; cp = cp * r2 + 1.0 / 24.0; cp = cp * r2 - 0.5; cp = cp * r2 + 1.0;
    const double sr = sp * r, cr = cp; const int q = (int)((long long)k & 3);
    const double cc = (q == 0) ? cr : (q == 1) ? -sr : (q == 2) ? -cr : sr;
    const double sv = (q == 0) ? sr : (q == 1) ? cr : (q == 2) ? -sr : -cr;
    c = (float)cc; s = (float)sv;
}

__device__ __forceinline__ void ffn_edge_fix(const pg8::StaticOrder& S, const float* EDGE, const float* cw, bf16* ACT) {
    int tid_ = threadIdx.x; asm volatile("" : "+v"(tid_)); const int tid = tid_;
    pg8::Unit u;
    for (int i = 0; S.next(i, u); ++i) {
        const int pm = u.pm, pmod = pm & 7;
        for (int idx = tid; idx < 2 * (FF / 4); idx += NWAVES * 64) {
            const int r = idx / (FF / 4), c = (idx % (FF / 4)) * 4;
            if ((r == 0 && pmod == 0) || (r == 1 && pmod == 7)) continue;
            const float* ep = EDGE + ((size_t)(pm * 2 + r) * 3) * FF + c;
            const float* nb = EDGE + ((size_t)((r == 0 ? pm - 1 : pm + 1) * 2 + (r == 0 ? 1 : 0)) * 3 + 2) * FF + c;
            const f32x4 zp = *(const f32x4*)ep, uu = *(const f32x4*)(ep + FF), gn = *(const f32x4*)nb, w = *(const f32x4*)(cw + (r == 0 ? 0 : 2 * FF) + c);
            f32x4 o;
#pragma unroll
            for (int e = 0; e < 4; ++e) { const float z = zp[e] + w[e] * gn[e]; o[e] = z * __builtin_amdgcn_rcpf(1.0f + __builtin_amdgcn_exp2f(z * -1.4426950408889634f)) * uu[e]; }
            u32x2 pk; pk.x = pg8::cvt_pk_bf16(o[0], o[1]); pk.y = pg8::cvt_pk_bf16(o[2], o[3]);
            *(u32x2*)(ACT + (size_t)(pm * 256 + (r == 0 ? 0 : 255)) * FF + c) = pk;
        }
    }
    asm volatile("s_waitcnt vmcnt(0)" ::: "memory"); __syncthreads();
}

#ifndef PHASES
#define PHASES 0xffff
#endif
#define PH(k) ((PHASES >> (k)) & 1)
#ifndef DUP_MASK
#define DUP_MASK 0
#endif
#define REP(k) for (int rep_ = 0; rep_ < 1 + ((DUP_MASK >> (k)) & 1); ++rep_)
struct Args { const float* in[12]; float* out; unsigned char* ws; };

typedef const Args __attribute__((address_space(4)))* ArgsP;
#define PTRS ArgsP ap_ = (ArgsP)__builtin_amdgcn_kernarg_segment_ptr(); asm volatile("" : "+s"(ap_)); \
    unsigned char* ws = ap_->ws; (void)ws; \
    const float* x = ap_->in[0]; const int* positions = (const int*)ap_->in[1]; const float* w_qkv = ap_->in[2]; const float* sink = ap_->in[3]; const float* w_o = ap_->in[4]; \
    const float* w_in = ap_->in[5]; const float* conv_w = ap_->in[6]; const float* w_out = ap_->in[7]; const float* gains = ap_->in[8]; const float* w_gu = ap_->in[9]; \
    const float* ffn_cw = ap_->in[10]; const float* w_dn = ap_->in[11]; float* out = ap_->out; \
    bf16* Wqkv_t = (bf16*)(ws + WS_WQKV); bf16* Wo_t = (bf16*)(ws + WS_WO); bf16* Win_t = (bf16*)(ws + WS_WIN); bf16* Wout_t = (bf16*)(ws + WS_WOUT); \
    bf16* Wgu_t = (bf16*)(ws + WS_WGU); bf16* Wd_t = (bf16*)(ws + WS_WD); float* rcos = (float*)(ws + WS_ROPE); float* rsin = rcos + SEQ * 32; \
    float* RS = (float*)(ws + WS_RS); (void)RS; bf16* XN = (bf16*)(ws + WS_XN); float* EDGE = (float*)(ws + WS_EDGE); (void)EDGE; bf16* Y = (bf16*)(ws + WS_Y); bf16* ACT = (bf16*)(ws + WS_ACT); \
    bf16* QB = (bf16*)(ws + WS_Q); bf16* KB = (bf16*)(ws + WS_K); bf16* VT = (bf16*)(ws + WS_VT); bf16* PB = (bf16*)(ws + WS_P); bf16* Y2 = (bf16*)(ws + WS_Y2); \
    (void)x; (void)positions; (void)w_qkv; (void)sink; (void)w_o; (void)w_in; (void)conv_w; (void)w_out; (void)gains; (void)w_gu; (void)ffn_cw; (void)w_dn; (void)out; \
    (void)Wqkv_t; (void)Wo_t; (void)Win_t; (void)Wout_t; (void)Wgu_t; (void)Wd_t; (void)rcos; (void)rsin; (void)XN; (void)Y; (void)ACT; (void)QB; (void)KB; (void)VT; (void)PB; (void)Y2; \
    const int G = gridDim.x; (void)G

__global__ void __launch_bounds__(NWAVES * 64, 2) fwd_megakernel(Args args) {
    extern __shared__ __attribute__((aligned(16))) unsigned char lds_raw[];
    LAS unsigned char* lds = (LAS unsigned char*)lds_raw;
    cg::grid_group grid = cg::this_grid();
#define SYNC() do { ArgsP bp_ = (ArgsP)__builtin_amdgcn_kernarg_segment_ptr(); XcdBarrier b_; b_.bar = (unsigned*)(bp_->ws + WS_CTL); b_.x = xb_xcc_id(); b_.st = (volatile LAS unsigned*)(lds + LDS_BARST); xcd_barrier(b_); } while (0)
    if (threadIdx.x == 0) { ((volatile LAS unsigned*)(lds + LDS_BARST))[0] = 0u; ((volatile LAS unsigned*)(lds + LDS_BARST))[1] = 0u; }
    if (blockIdx.x == 0) { unsigned* ctl = (unsigned*)(args.ws + WS_CTL); for (int i = threadIdx.x; i < BAR_WORDS; i += NWAVES * 64) ctl[i] = 0u; }
    __syncthreads();

    REP(0) if (PH(0)) {
        PTRS;
        int tid_ = threadIdx.x; asm volatile("" : "+v"(tid_)); const int tid = tid_, lane = tid & 63, wave = __builtin_amdgcn_readfirstlane(tid >> 6);
        LAS float* scr = (LAS float*)(lds + wave * 16384);
        const int gw = blockIdx.x * NWAVES + wave, NGW = G * NWAVES;
        constexpr int I_QKV = 16 * (NQKV / 32), I_O = 16 * 32, I_IN = 16 * 96, I_OUT = 16 * 32, I_GU = 16 * (2 * FF / 32), I_D = (FF / 64) * 32;
        constexpr int NITEMS = I_QKV + I_O + I_IN + I_OUT + 2 * I_GU + 2 * I_D;
        for (int it = gw; it < NITEMS; it += NGW) {
            int r = it;
            if (r < I_QKV) { transpose_item(w_qkv, DM, NQKV, Wqkv_t, 1, gains, scr, r, lane); continue; } r -= I_QKV;
            if (r < I_O) { transpose_item(w_o, DM, DM, Wo_t, 0, nullptr, scr, r, lane); continue; } r -= I_O;
            if (r < I_IN) { transpose_item(w_in, DM, 3 * DM, Win_t, 2, gains + 4 * DM, scr, r, lane); continue; } r -= I_IN;
            if (r < I_OUT) { transpose_item(w_out, DM, DM, Wout_t, 0, nullptr, scr, r, lane); continue; } r -= I_OUT;
            if (r < I_GU) { transpose_item(w_gu, DM, 2 * FF, Wgu_t, 3, gains + 2 * DM, scr, r, lane); continue; } r -= I_GU;
            if (r < I_GU) { transpose_item(w_gu + (size_t)DM * 2 * FF, DM, 2 * FF, Wgu_t + (size_t)2 * FF * DM, 3, gains + 6 * DM, scr, r, lane); continue; } r -= I_GU;
            if (r < I_D) { transpose_item(w_dn, FF, DM, Wd_t, 0, nullptr, scr, r, lane); continue; } r -= I_D;
            transpose_item(w_dn + (size_t)FF * DM, FF, DM, Wd_t + (size_t)DM * FF, 0, nullptr, scr, r, lane);
        }
        for (int e = blockIdx.x * (NWAVES * 64) + tid; e < SEQ * 32; e += G * NWAVES * 64) {
            const int s = e >> 5, i = e & 31; const float ang = (float)positions[s] * INV_FREQ[i];
            float c, sn; sincos_f64(ang, c, sn); rcos[e] = c; rsin[e] = sn;
        }
        cast_rows(x, XN, RS);
    }
    grid.sync();
    if (threadIdx.x == 0) (void)xb_add(&((unsigned*)(args.ws + WS_CTL))[XB_XCNT(xb_xcc_id())], 1u);
    REP(1) if (PH(1)) {
        PTRS;
        pg8::Gemm g{XN, Wqkv_t, MTOK, 1280, DM, Wqkv_t + (size_t)1280 * DM, XN}; pg8::StaticOrder S; S.init(MTOK, 1280, G, (int)blockIdx.x, MTOK / 256);
        pg8::EpiQKV E{QB, (long)((WS_K - WS_Q) / 2), (long)((WS_VT - WS_Q) / 2), rcos, rsin, RS, 0.125f * LOG2E, MTOK};
        pg8::gemm_phase<pg8::EpiQKV, pg8::StaticOrder, true, true>(lds, g, S, E);
    }
    SYNC();
#ifdef PROBE_ATT2
    { PTRS; att::attn_phase(lds, QB, (bf16*)(ws + WS_END), KB, VT, sink); }
#endif
    if (PH(2)) { PTRS; att::attn_phase(lds, QB, QB, KB, VT, sink); }
    SYNC();
    REP(3) if (PH(3)) {
        PTRS;
        pg8::Gemm g{QB, Wo_t, MTOK, DM, DM, nullptr, nullptr}; pg8::StaticOrder S; S.init(MTOK, DM, G, (int)blockIdx.x);
        pg8::EpiStore E{Y, DM};
        pg8::gemm_phase<pg8::EpiStore, pg8::StaticOrder, true, true>(lds, g, S, E);
    }
    SYNC();
    REP(4) if (PH(4)) { PTRS; seam_pass<true, false>(x, XN, Y, gains + 1 * DM, nullptr, RS); }
    SYNC();
#pragma unroll 1
    for (int layer = 0; layer < 2; ++layer) {
        if (PH(5) && layer == 1) {
            REP(7) if (PH(7)) {
                PTRS;
                pg8::Gemm g{XN, Win_t, MTOK, 2048, DM, nullptr, nullptr}; pg8::StaticOrder S; S.init(MTOK, 2048, G, (int)blockIdx.x);
                pg8::EpiCX E{PB, RS};
                pg8::gemm_phase<pg8::EpiCX, pg8::StaticOrder, true, true>(lds, g, S, E);
            }
            SYNC();
            REP(8) if (PH(8)) {
                PTRS;
                pg8::Gemm g{XN, Win_t + (size_t)2048 * DM, MTOK, DM, DM, nullptr, nullptr}; pg8::StaticOrder S; S.init(MTOK, DM, G, (int)blockIdx.x);
                pg8::EpiConv<0> E{PB, conv_w, Y2, DM, RS};
                pg8::gemm_phase<pg8::EpiConv<0>, pg8::StaticOrder, true, true>(lds, g, S, E);
            }
            SYNC();
            REP(9) if (PH(9)) {
                PTRS;
                pg8::Gemm g{Y2, Wout_t, MTOK, DM, DM, nullptr, nullptr}; pg8::StaticOrder S; S.init(MTOK, DM, G, (int)blockIdx.x);
                pg8::EpiStore E{Y, DM};
                pg8::gemm_phase<pg8::EpiStore, pg8::StaticOrder, true, true>(lds, g, S, E);
            }
            SYNC();
            { PTRS; seam_pass<false, false>(nullptr, XN, Y, gains + 5 * DM, nullptr, RS); }
            SYNC();
        }
        if (!PH(6)) continue;
        REP(11) if (PH(11)) {
            PTRS; const bf16* Wg = Wgu_t + (size_t)layer * 2 * FF * DM;
            pg8::Gemm g{XN, Wg, MTOK, 2 * FF, DM, nullptr, nullptr}; pg8::StaticOrder S; S.init(MTOK, 2 * FF, G, (int)blockIdx.x);
            pg8::EpiGU E{EDGE, ffn_cw + (size_t)layer * 3 * FF, ACT, lds + LDS_XCH, FF, RS};
            pg8::gemm_phase<pg8::EpiGU, pg8::StaticOrder, true, true>(lds, g, S, E);
        }
        SYNC();
#ifdef PROBE_PLAINUP
        if (layer == 0) {
            PTRS; const bf16* Wg = Wgu_t + (size_t)layer * 2 * FF * DM;
            pg8::Gemm g{XN, Wg, MTOK, 2 * FF, DM, nullptr, nullptr}; pg8::StaticOrder S; S.init(MTOK, 2 * FF, G, (int)blockIdx.x);
            pg8::EpiStore E{(bf16*)(ws + WS_END), DM};
            pg8::gemm_phase<pg8::EpiStore, pg8::StaticOrder, true, true>(lds, g, S, E);
        }
#endif
        REP(12) if (PH(12)) {
            PTRS; const bf16* Wd = Wd_t + (size_t)layer * DM * FF;
            pg8::Gemm g{ACT, Wd, MTOK, DM, FF, nullptr, nullptr}; pg8::StaticOrder S; S.init(MTOK, DM, G, (int)blockIdx.x);
            ffn_edge_fix(S, EDGE, ffn_cw + (size_t)layer * 3 * FF, ACT);
            pg8::EpiStore E{Y, DM};
            pg8::gemm_phase<pg8::EpiStore, pg8::StaticOrder, true, true>(lds, g, S, E);
        }
        SYNC();
        { PTRS; if (layer == 0) seam_pass<false, false>(nullptr, XN, Y, gains + 3 * DM, nullptr, RS); else seam_pass<false, true>(nullptr, XN, Y, gains + 7 * DM, out, nullptr); }
        if (layer == 0) SYNC();
    }
}

extern "C" void kernel_launch(void* const* d_in, const int* in_sizes, int n_in, void* d_out, int out_size, void* d_ws, size_t ws_size, hipStream_t stream) {
    static int grid = 0;
    if (grid == 0) {
        if (n_in != 12 || in_sizes[0] != MTOK * DM || out_size != MTOK * DM || ws_size < WS_END) { fprintf(stderr, "kernel_launch: unexpected shapes / workspace (n_in %d, in0 %d, out %d, ws %zu)\n", n_in, n_in > 0 ? in_sizes[0] : -1, out_size, ws_size); grid = -1; return; }
        int dev = 0, cus = 0, per_cu = 0;
        hipGetDevice(&dev); hipDeviceGetAttribute(&cus, hipDeviceAttributeMultiprocessorCount, dev);
        if (hipFuncSetAttribute((const void*)fwd_megakernel, hipFuncAttributeMaxDynamicSharedMemorySize, LDS_BYTES) != hipSuccess) { fprintf(stderr, "kernel_launch: hipFuncSetAttribute failed\n"); grid = -1; return; }
        if (hipOccupancyMaxActiveBlocksPerMultiprocessor(&per_cu, (const void*)fwd_megakernel, NWAVES * 64, LDS_BYTES) != hipSuccess || per_cu < 1) { fprintf(stderr, "kernel_launch: occupancy query says %d\n", per_cu); per_cu = 1; }
        (void)hipGetLastError();
        grid = cus * per_cu;
    }
    if (grid < 0) return;
    Args a{};
    for (int i = 0; i < 12; ++i) a.in[i] = (const float*)d_in[i];
    a.out = (float*)d_out; a.ws = (unsigned char*)d_ws;
    void* kargs[] = {&a};
    hipError_t e = hipLaunchCooperativeKernel((const void*)fwd_megakernel, dim3(grid), dim3(NWAVES * 64), kargs, LDS_BYTES, stream);
    if (e != hipSuccess) fprintf(stderr, "kernel_launch: cooperative launch failed: %s (grid %d)\n", hipGetErrorString(e), grid);
}
```
